# Optimizing an MI355X kernel written in HIP

```python
import jax, jax.numpy as jnp
from jax import lax
import numpy as np

D_MODEL = 2048
BATCH = 4
SEQ = 2048
DEPTH = 1
DEC_BATCH = 128
DEC_SEQ = 8
PAST_LEN = 16384
PAGE_SIZE = 128

LRU_WIDTH = D_MODEL // 2
SC_WIDTH = D_MODEL - LRU_WIDTH
LRU_HEADS = 16
LRU_HEAD_DIM = LRU_WIDTH // LRU_HEADS
LRU_CONV = 4
LRU_C = 8.0
SC_GROUPS = 16
SC_CONV = 3
IN_COLS = 2 * LRU_WIDTH + 3 * SC_WIDTH
PEER_HEADS = 8
N_KEYS = 128
N_EXPERTS = N_KEYS * N_KEYS
PEER_TOPK = 16
QUERY_DIM = 256
HALF_DIM = QUERY_DIM // 2
PEER_BLOCK = 128
EPS = 1e-6

kernel_name = "hymba_rglru_shortconv_peer_adaln_step"


def rmsnorm(x, g):
    xf = x.astype(jnp.float32)
    y = xf * lax.rsqrt(jnp.mean(xf * xf, axis=-1, keepdims=True) + EPS)
    return (y * g.astype(jnp.float32)).astype(x.dtype)


def modulate(h, shift, scale):
    return h * (1 + scale[:, None, :]) + shift[:, None, :]


def causal_dwconv(x, buf, w):
    width = w.shape[0]
    s = x.shape[1]
    xp = jnp.concatenate([buf.astype(x.dtype), x], axis=1)
    out = w[0] * xp[:, 0:s]
    for k in range(1, width):
        out = out + w[k] * xp[:, k:k + s]
    return out, xp[:, -(width - 1):]


def rglru(x, h0, w_a, b_a, w_x, b_x, lam):
    b, s, _ = x.shape
    xh = x.reshape(b, s, LRU_HEADS, LRU_HEAD_DIM)
    r = jax.nn.sigmoid((jnp.einsum('bshi,hij->bshj', xh, w_a).reshape(b, s, LRU_WIDTH) + b_a).astype(jnp.float32))
    i = jax.nn.sigmoid((jnp.einsum('bshi,hij->bshj', xh, w_x).reshape(b, s, LRU_WIDTH) + b_x).astype(jnp.float32))
    log_a = -LRU_C * r * jax.nn.softplus(-lam.astype(jnp.float32))
    a = jnp.exp(log_a)
    u = jnp.sqrt(-jnp.expm1(2.0 * log_a)) * (i * x.astype(jnp.float32))

    def step(h, au):
        a_t, u_t = au
        h = a_t * h + u_t
        return h, h

    h_last, hs = lax.scan(step, h0.astype(jnp.float32),
                          (jnp.swapaxes(a, 0, 1), jnp.swapaxes(u, 0, 1)))
    return jnp.swapaxes(hs, 0, 1).astype(x.dtype), h_last.astype(x.dtype)


def peer(h, w_q, sub_keys, expert_u, expert_v):
    b, s, d = h.shape
    t = h.reshape(-1, d)
    n_tok = t.shape[0]
    nb = -(-n_tok // PEER_BLOCK)
    t = jnp.pad(t, ((0, nb * PEER_BLOCK - n_tok), (0, 0)))

    def block(xb):
        q = (xb @ w_q).reshape(PEER_BLOCK, PEER_HEADS, 2, HALF_DIM)
        sc = jnp.einsum('thpk,pnk->thpn', q, sub_keys).astype(jnp.float32)
        v1, i1 = lax.top_k(sc[:, :, 0], PEER_TOPK)
        v2, i2 = lax.top_k(sc[:, :, 1], PEER_TOPK)
        cand = (v1[..., :, None] + v2[..., None, :]).reshape(PEER_BLOCK, PEER_HEADS, PEER_TOPK * PEER_TOPK)
        cidx = (i1[..., :, None] * N_KEYS + i2[..., None, :]).reshape(PEER_BLOCK, PEER_HEADS, PEER_TOPK * PEER_TOPK)
        top, pos = lax.top_k(cand, PEER_TOPK)
        eidx = jnp.take_along_axis(cidx, pos, axis=-1)
        g = jax.nn.softmax(top, axis=-1).astype(xb.dtype)
        act = jax.nn.gelu(jnp.einsum('td,thkd->thk', xb, expert_u[eidx])) * g
        return jnp.einsum('thk,thkd->td', act, expert_v[eidx])

    out = lax.map(block, t.reshape(nb, PEER_BLOCK, d)).reshape(-1, d)[:n_tok]
    return out.reshape(b, s, d)


def layer(x, c, h0, lru_buf, sc_buf, w_ada, b_ada, norm1_g, norm2_g, w_in,
          lru_conv_w, lru_conv_b, lru_wa, lru_ba, lru_wx, lru_bx, lru_lambda,
          sconv_w, gnorm_lru_g, gnorm_sc_g, w_out, peer_wq, peer_sub_keys, peer_u, peer_v):
    mod = (jax.nn.silu(c) @ w_ada + b_ada).reshape(c.shape[0], 6, D_MODEL)
    shift1, scale1, gate1, shift2, scale2, gate2 = [mod[:, k] for k in range(6)]

    h = modulate(rmsnorm(x, norm1_g), shift1, scale1)
    proj = h @ w_in
    x_lru, y_gate, sc_b, sc_c, sc_x = jnp.split(
        proj, [LRU_WIDTH, 2 * LRU_WIDTH, 2 * LRU_WIDTH + SC_WIDTH, 2 * LRU_WIDTH + 2 * SC_WIDTH], axis=-1)

    xc, new_lru_buf = causal_dwconv(x_lru, lru_buf, lru_conv_w)
    rec, h_last = rglru(xc + lru_conv_b, h0, lru_wa, lru_ba, lru_wx, lru_bx, lru_lambda)
    out_lru = rec * jax.nn.gelu(y_gate)

    conv_out, new_sc_buf = causal_dwconv(sc_c * sc_x, sc_buf, sconv_w)
    out_sc = sc_b * conv_out

    mix = jnp.concatenate([rmsnorm(out_lru, gnorm_lru_g), rmsnorm(out_sc, gnorm_sc_g)], axis=-1) @ w_out
    x = x + gate1[:, None, :] * mix

    h2 = modulate(rmsnorm(x, norm2_g), shift2, scale2)
    x = x + gate2[:, None, :] * peer(h2, peer_wq, peer_sub_keys, peer_u, peer_v)
    return x, h_last, new_lru_buf, new_sc_buf


def setup_inputs(seed: int = 0) -> dict:
    key = jax.random.key(seed)
    ks = jax.random.split(key, 32)
    f32 = jnp.float32
    nrm = lambda k, shape, s: jax.random.normal(k, shape, f32) * s
    d = D_MODEL
    a0 = jax.random.uniform(ks[20], (DEPTH, LRU_WIDTH), f32, 0.9, 0.999)
    sig = a0 ** (1.0 / LRU_C)
    return {
        "x_prompt": nrm(ks[0], (BATCH, SEQ, d), 1.0),
        "x_sample": nrm(ks[1], (DEC_BATCH, DEC_SEQ, d), 1.0),
        "c_prompt": nrm(ks[2], (BATCH, d), 1.0),
        "c_sample": nrm(ks[3], (DEC_BATCH, d), 1.0),
        "state_lru_h": nrm(ks[4], (DEPTH, DEC_BATCH, LRU_WIDTH), 0.5),
        "state_lru_conv": nrm(ks[5], (DEPTH, DEC_BATCH, LRU_CONV - 1, LRU_WIDTH), 1.0),
        "state_sconv": nrm(ks[6], (DEPTH, DEC_BATCH, SC_CONV - 1, SC_WIDTH), 1.0),
        "w_ada": nrm(ks[7], (DEPTH, d, 6 * d), 0.3 * d ** -0.5),
        "b_ada": nrm(ks[8], (DEPTH, 6 * d), 0.01),
        "norm1_g": 1.0 + nrm(ks[9], (DEPTH, d), 0.02),
        "norm2_g": 1.0 + nrm(ks[10], (DEPTH, d), 0.02),
        "w_in": nrm(ks[11], (DEPTH, d, IN_COLS), d ** -0.5),
        "lru_conv_w": nrm(ks[12], (DEPTH, LRU_CONV, LRU_WIDTH), LRU_CONV ** -0.5),
        "lru_conv_b": nrm(ks[13], (DEPTH, LRU_WIDTH), 0.01),
        "lru_wa": nrm(ks[14], (DEPTH, LRU_HEADS, LRU_HEAD_DIM, LRU_HEAD_DIM), LRU_HEAD_DIM ** -0.5),
        "lru_ba": nrm(ks[15], (DEPTH, LRU_WIDTH), 0.01),
        "lru_wx": nrm(ks[16], (DEPTH, LRU_HEADS, LRU_HEAD_DIM, LRU_HEAD_DIM), LRU_HEAD_DIM ** -0.5),
        "lru_bx": nrm(ks[17], (DEPTH, LRU_WIDTH), 0.01),
        "lru_lambda": jnp.log(sig / (1.0 - sig)),
        "sconv_w": nrm(ks[18], (DEPTH, SC_CONV, SC_WIDTH), SC_CONV ** -0.5),
        "gnorm_lru_g": 1.0 + nrm(ks[19], (DEPTH, LRU_WIDTH), 0.02),
        "gnorm_sc_g": 1.0 + nrm(ks[21], (DEPTH, SC_WIDTH), 0.02),
        "w_out": nrm(ks[22], (DEPTH, d, d), d ** -0.5),
        "peer_wq": nrm(ks[23], (DEPTH, d, PEER_HEADS * QUERY_DIM), d ** -0.5),
        "peer_sub_keys": nrm(ks[24], (DEPTH, 2, N_KEYS, HALF_DIM), HALF_DIM ** -0.5),
        "peer_u": nrm(ks[25], (DEPTH, N_EXPERTS, d), d ** -0.5),
        "peer_v": nrm(ks[26], (DEPTH, N_EXPERTS, d), 0.3),
        "final_g": 1.0 + nrm(ks[27], (d,), 0.02),
    }


def reference(x_prompt, x_sample, c_prompt, c_sample, state_lru_h, state_lru_conv, state_sconv,
              w_ada, b_ada, norm1_g, norm2_g, w_in, lru_conv_w, lru_conv_b, lru_wa, lru_ba,
              lru_wx, lru_bx, lru_lambda, sconv_w, gnorm_lru_g, gnorm_sc_g, w_out,
              peer_wq, peer_sub_keys, peer_u, peer_v, final_g):
    xp, xs = x_prompt, x_sample
    bp = x_prompt.shape[0]
    zero_h = jnp.zeros((bp, LRU_WIDTH), x_prompt.dtype)
    zero_lbuf = jnp.zeros((bp, LRU_CONV - 1, LRU_WIDTH), x_prompt.dtype)
    zero_sbuf = jnp.zeros((bp, SC_CONV - 1, SC_WIDTH), x_prompt.dtype)
    hp_l, lbp_l, sbp_l, hs_l, lbs_l, sbs_l = [], [], [], [], [], []
    for l in range(DEPTH):
        lp = (w_ada[l], b_ada[l], norm1_g[l], norm2_g[l], w_in[l], lru_conv_w[l], lru_conv_b[l],
              lru_wa[l], lru_ba[l], lru_wx[l], lru_bx[l], lru_lambda[l], sconv_w[l],
              gnorm_lru_g[l], gnorm_sc_g[l], w_out[l], peer_wq[l], peer_sub_keys[l], peer_u[l], peer_v[l])
        xp, hp, lbp, sbp = layer(xp, c_prompt, zero_h, zero_lbuf, zero_sbuf, *lp)
        xs, hs, lbs, sbs = layer(xs, c_sample, state_lru_h[l], state_lru_conv[l], state_sconv[l], *lp)
        hp_l.append(hp); lbp_l.append(lbp); sbp_l.append(sbp)
        hs_l.append(hs); lbs_l.append(lbs); sbs_l.append(sbs)
    y_prompt = rmsnorm(xp, final_g)
    y_sample = rmsnorm(xs, final_g)
    return (y_prompt, y_sample,
            jnp.stack(hp_l), jnp.stack(lbp_l), jnp.stack(sbp_l),
            jnp.stack(hs_l), jnp.stack(lbs_l), jnp.stack(sbs_l))
```

```cpp
#include <hip/hip_runtime.h>
#include <hip/hip_cooperative_groups.h>
#include <cstdio>
#include <cstdint>
namespace cg = cooperative_groups;

#ifndef MK_N_LAUNCHES
#define MK_N_LAUNCHES 1
#endif

namespace pg8 {
#define PG8_LAS __attribute__((address_space(3)))
typedef unsigned short bf16_t;
typedef short bf16x8 __attribute__((ext_vector_type(8)));
typedef float f32x4 __attribute__((ext_vector_type(4)));
typedef unsigned u32x4 __attribute__((ext_vector_type(4)));
constexpr int BM = 256, BK = 64, HALF = 128, HTB = HALF * BK * 2, STAGE_BYTES = 8 * HTB, NXCD = 8, WGM = 8;

__host__ __device__ __forceinline__ int lds_byte(int r, int c) { const int st = (r >> 4) * 2 + (c >> 5), rr = r & 15, cc = c & 31, ob = rr * 64 + cc * 2; return st * 1024 + (ob ^ (((ob >> 9) & 1) << 5)); }
__host__ __device__ __forceinline__ void stage_rc(int b, int& R, int& C) { const int st = b / 1024, sb = b % 1024, swz = sb ^ (((sb >> 9) & 1) << 5); R = (st >> 1) * 16 + swz / 64; C = (st & 1) * 32 + (swz % 64) / 2; }
__host__ __device__ __forceinline__ int perm32(int rho) { const int n = rho >> 4, i = rho & 15; return 8 * (i >> 2) + 4 * n + (i & 3); }

struct Unit { int pm, pn; };
struct Gemm { const bf16_t* A; const bf16_t* Bt; int M, N, K; };

struct StaticOrder {
    int nM, nN, nwg, G, c;
    __host__ __device__ void init(int M, int N, int G_, int c_) { nM = M / BM; nN = N / BM; nwg = nM * nN; G = G_; c = c_; }
    __host__ __device__ bool next(int i, Unit& u) const {
        const long L = (long)i * G + c; if (L >= nwg) return false;
        int wgid = (int)L; { const int q = nwg / NXCD, r = nwg % NXCD, xcd = wgid % NXCD, off = wgid / NXCD; wgid = (xcd < r ? xcd * (q + 1) : r * (q + 1) + (xcd - r) * q) + off; }
        const int nig = WGM * nN, gid = wgid / nig, fm = gid * WGM, gsz = (nM - fm) < WGM ? (nM - fm) : WGM;
        u.pm = fm + ((wgid % nig) % gsz); u.pn = (wgid % nig) / gsz; return true;
    }
    __device__ __forceinline__ void a_ready(const Unit&) const {}
    __device__ __forceinline__ void done(const Unit&) const {}
};

__device__ __forceinline__ unsigned cvt_pk_bf16(float lo, float hi) { unsigned r; asm volatile("v_cvt_pk_bf16_f32 %0, %1, %2" : "=v"(r) : "v"(lo), "v"(hi)); return r; }

struct EpiBf16 {
    static constexpr bool PERM = true, AFTER_DRAIN = false;
    bf16_t* O; int ldc;
    __device__ __forceinline__ void operator()(const f32x4 (&acc)[2][2][4][2], const Unit& u, int wr, int wc, int fr, int fq) const {
        const int row0 = u.pm * BM + wr * 64 + fr; const int col0 = u.pn * BM + wc * 32 + 8 * fq;
#pragma unroll
        for (int ai = 0; ai < 2; ++ai)
#pragma unroll
            for (int m = 0; m < 4; ++m) { bf16_t* rowp = O + (size_t)(row0 + ai * HALF + m * 16) * ldc + col0;
#pragma unroll
                for (int bj = 0; bj < 2; ++bj) { const f32x4 v0 = acc[ai][bj][m][0], v1 = acc[ai][bj][m][1];
                    u32x4 w; w.x = cvt_pk_bf16(v0[0], v0[1]); w.y = cvt_pk_bf16(v0[2], v0[3]); w.z = cvt_pk_bf16(v1[0], v1[1]); w.w = cvt_pk_bf16(v1[2], v1[3]);
                    *(u32x4*)(rowp + bj * HALF) = w; } }
    }
};

struct EpiResGate {
    static constexpr bool PERM = true, AFTER_DRAIN = false;
    const float* xp; const float* xs; const float* mod; float* O;
    __device__ __forceinline__ void operator()(const f32x4 (&acc)[2][2][4][2], const Unit& u, int wr, int wc, int fr, int fq) const {
        const int row0 = u.pm * BM + wr * 64 + fr; const int col0 = u.pn * BM + wc * 32 + 8 * fq;
#pragma unroll
        for (int ai = 0; ai < 2; ++ai)
#pragma unroll
            for (int m = 0; m < 4; ++m) {
                const int row = row0 + ai * HALF + m * 16;
                const float* xr = row < 8192 ? xp + (size_t)row * 2048 : xs + (size_t)(row - 8192) * 2048;
                const int mb = row < 8192 ? (row >> 11) : 4 + ((row - 8192) >> 3);
                const float* gr = mod + (size_t)mb * 12288 + 2 * 2048;
                float* orow = O + (size_t)row * 2048;
#pragma unroll
                for (int bj = 0; bj < 2; ++bj)
#pragma unroll
                    for (int n = 0; n < 2; ++n) { const int c = col0 + bj * HALF + 4 * n;
                        const f32x4 xv = *(const f32x4*)(xr + c), gv = *(const f32x4*)(gr + c);
                        *(f32x4*)(orow + c) = xv + gv * acc[ai][bj][m][n]; }
            }
    }
};

template <class Epi, class Sched, bool ALIGN_EPI = false>
__device__ __forceinline__ void gemm_phase(PG8_LAS unsigned char* lds, const Gemm g, const Sched& S, const Epi& E) {
    const int tid = threadIdx.x, wid = __builtin_amdgcn_readfirstlane(tid >> 6), lane = tid & 63, wr = wid >> 2, wc = wid & 3, fr = lane & 15, fq = lane >> 4;
    const int K = g.K, nt = K / BK;
    unsigned voffA[2], voffB[2];
#pragma unroll
    for (int i = 0; i < 2; ++i) { int R, C; stage_rc(tid * 16 + i * 8192, R, C); const int Rb = Epi::PERM ? ((R & ~31) + perm32(R & 31)) : R;
        voffA[i] = (unsigned)(R * K + C) * 2u; voffB[i] = (unsigned)(Rb * K + C) * 2u; }
    const size_t kstep = (size_t)(BK * 2);
    const size_t hstep = (size_t)HALF * K * 2;
    const size_t tstep = 2 * hstep;
    const unsigned ldsw = (unsigned)wid * 1024u;
    const int aoff = lds_byte(wr * 64 + fr, fq * 8), boff = lds_byte(wc * 32 + fr, fq * 8);
#define PG8_SA(b, h) (((b) * 2 + (h)) * HTB)
#define PG8_SB(b, h) ((4 + (b) * 2 + (h)) * HTB)
#define PG8_STAGE(bufoff, gbase, voff) do { _Pragma("unroll") for (int _i = 0; _i < 2; ++_i) \
        __builtin_amdgcn_global_load_lds((const unsigned*)((const char*)(gbase) + (voff)[_i]), (PG8_LAS unsigned*)(lds + (bufoff) + ldsw + _i * 8192), 16, 0, 0); } while (0)
#define PG8_LDA(dst, b, h) do { _Pragma("unroll") for (int m = 0; m < 4; ++m) _Pragma("unroll") for (int k = 0; k < 2; ++k) dst[m][k] = *(const PG8_LAS bf16x8*)(lds + PG8_SA(b, h) + aoff + m * 2048 + k * 1024); } while (0)
#define PG8_LDB(dst, b, h) do { _Pragma("unroll") for (int n = 0; n < 2; ++n) _Pragma("unroll") for (int k = 0; k < 2; ++k) dst[n][k] = *(const PG8_LAS bf16x8*)(lds + PG8_SB(b, h) + boff + n * 2048 + k * 1024); } while (0)
#define PG8_MMA(ai, bj, At, Bt) do { __builtin_amdgcn_s_setprio(1); _Pragma("unroll") for (int m = 0; m < 4; ++m) _Pragma("unroll") for (int n = 0; n < 2; ++n) _Pragma("unroll") for (int k = 0; k < 2; ++k) \
        acc[ai][bj][m][n] = __builtin_amdgcn_mfma_f32_16x16x32_bf16(Bt[n][k], At[m][k], acc[ai][bj][m][n], 0, 0, 0); __builtin_amdgcn_s_setprio(0); } while (0)
#define PG8_WAIT_V(n) asm volatile("s_waitcnt vmcnt(" #n ")" ::: "memory")
#define PG8_WAIT_L(n) asm volatile("s_waitcnt lgkmcnt(" #n ")" ::: "memory")
#define PG8_BAR __builtin_amdgcn_s_barrier()
#define PG8_SCHED __builtin_amdgcn_sched_barrier(0)
    Unit cur, nxt; int ui = 0;
    if (!S.next(0, cur)) return;
    f32x4 acc[2][2][4][2];
#pragma unroll
    for (int a = 0; a < 2; ++a)
#pragma unroll
        for (int b = 0; b < 2; ++b)
#pragma unroll
            for (int m = 0; m < 4; ++m)
#pragma unroll
                for (int n = 0; n < 2; ++n) acc[a][b][m][n] = (f32x4){0.f, 0.f, 0.f, 0.f};
    bf16x8 At[4][2], B0[2][2], B1[2][2];
    const char* cA = (const char*)g.A + (size_t)cur.pm * tstep; const char* cB = (const char*)g.Bt + (size_t)cur.pn * tstep;
    S.a_ready(cur);
    PG8_STAGE(PG8_SB(0, 0), cB, voffB); PG8_STAGE(PG8_SB(0, 1), cB + hstep, voffB); PG8_STAGE(PG8_SA(0, 0), cA, voffA); PG8_STAGE(PG8_SA(0, 1), cA + hstep, voffA);
    if (wr == 1) PG8_BAR;
    PG8_WAIT_V(2); PG8_BAR;
    PG8_STAGE(PG8_SB(1, 0), cB + kstep, voffB); PG8_STAGE(PG8_SA(1, 0), cA + kstep, voffA); PG8_STAGE(PG8_SB(1, 1), cB + hstep + kstep, voffB);
    PG8_WAIT_V(6); PG8_BAR;
    for (;;) {
        const bool has_next = S.next(ui + 1, nxt);
        const char* nA = has_next ? (const char*)g.A + (size_t)nxt.pm * tstep : cA; const char* nB = has_next ? (const char*)g.Bt + (size_t)nxt.pn * tstep : cB;
        for (int t = 0; t < nt; t += 2) {
            const bool last = (t == nt - 2);
            const char* a1 = cA + (size_t)(t + 1) * kstep;
            const char* a2 = last ? nA : cA + (size_t)(t + 2) * kstep; const char* b2 = last ? nB : cB + (size_t)(t + 2) * kstep;
            const char* a3 = a2 + kstep; const char* b3 = b2 + kstep;
            if (last && has_next) S.a_ready(nxt);
            PG8_LDB(B0, 0, 0); PG8_LDB(B1, 0, 1); PG8_SCHED; PG8_LDA(At, 0, 0); PG8_STAGE(PG8_SA(1, 1), a1 + hstep, voffA);
            PG8_WAIT_V(8); PG8_WAIT_L(0); PG8_BAR; PG8_MMA(0, 0, At, B0); PG8_MMA(0, 1, At, B1); PG8_BAR; PG8_SCHED;
            PG8_LDA(At, 0, 1); PG8_STAGE(PG8_SB(0, 0), b2, voffB); PG8_STAGE(PG8_SB(0, 1), b2 + hstep, voffB); PG8_STAGE(PG8_SA(0, 0), a2, voffA);
            PG8_WAIT_V(8); PG8_WAIT_L(0); PG8_BAR; PG8_MMA(1, 0, At, B0); PG8_MMA(1, 1, At, B1); PG8_BAR; PG8_SCHED;
            PG8_LDB(B0, 1, 0); PG8_LDB(B1, 1, 1); PG8_SCHED; PG8_LDA(At, 1, 0); PG8_STAGE(PG8_SA(0, 1), a2 + hstep, voffA);
            PG8_WAIT_V(8); PG8_WAIT_L(0); PG8_BAR; PG8_MMA(0, 0, At, B0); PG8_MMA(0, 1, At, B1); PG8_BAR; PG8_SCHED;
            PG8_LDA(At, 1, 1); PG8_STAGE(PG8_SB(1, 0), b3, voffB); PG8_STAGE(PG8_SB(1, 1), b3 + hstep, voffB); PG8_STAGE(PG8_SA(1, 0), a3, voffA);
            PG8_WAIT_V(8); PG8_WAIT_L(0); PG8_BAR; PG8_MMA(1, 0, At, B0); PG8_MMA(1, 1, At, B1); PG8_BAR; PG8_SCHED;
        }
        if constexpr (ALIGN_EPI) { if (wr == 0) PG8_BAR; }
        E(acc, cur, wr, wc, fr, fq); S.done(cur);
        if (!has_next) break;
#pragma unroll
        for (int a = 0; a < 2; ++a)
#pragma unroll
            for (int b = 0; b < 2; ++b)
#pragma unroll
                for (int m = 0; m < 4; ++m)
#pragma unroll
                    for (int n = 0; n < 2; ++n) acc[a][b][m][n] = (f32x4){0.f, 0.f, 0.f, 0.f};
        cur = nxt; cA = nA; cB = nB; ++ui;
        if constexpr (ALIGN_EPI) { if (wr == 1) PG8_BAR; }
    }
    PG8_WAIT_V(0);
    if constexpr (!ALIGN_EPI) { if (wr == 0) PG8_BAR; }
    PG8_BAR;
#undef PG8_SA
#undef PG8_SB
#undef PG8_STAGE
#undef PG8_LDA
#undef PG8_LDB
#undef PG8_MMA
#undef PG8_WAIT_V
#undef PG8_WAIT_L
#undef PG8_BAR
#undef PG8_SCHED
}
}

constexpr int NWAVES = 8;
constexpr int DM = 2048, NTOK = 9216, NPROMPT = 8192, NMOD = 132, MODW = 12288;
constexpr int LW = 1024, INC = 5120;
constexpr int NEXP = 16384;
constexpr float EPS = 1e-6f;
constexpr size_t O_Y = 0, O_HP = 18874368, O_LCP = 18878464, O_SCP = 18890752, O_HS = 18898944, O_LCS = 19030016, O_SCS = 19423232;
constexpr size_t MiB = 1u << 20;
constexpr size_t WS_CTL = 0, CTL_ZERO_BYTES = 1 * MiB;
constexpr size_t WS_S = 1 * MiB;
constexpr size_t WS_WAT = 2 * MiB;
constexpr size_t WS_MOD = 4 * MiB;
constexpr size_t WS_WIN = 12 * MiB;
constexpr size_t WS_WOUT = 32 * MiB;
constexpr size_t WS_WQ = 40 * MiB;
constexpr size_t WS_UB = 48 * MiB;
constexpr size_t WS_VB = 112 * MiB;
constexpr size_t WS_HBUF = 176 * MiB;
constexpr size_t WS_PROJ = 212 * MiB;
constexpr size_t WS_HLOC = 302 * MiB;
constexpr size_t WS_PCUM = 338 * MiB;
constexpr size_t WS_ENDS = 374 * MiB;
constexpr size_t WS_Q = 212 * MiB;
constexpr size_t WS_EIDX = 248 * MiB;
constexpr size_t WS_GW = 253 * MiB;
constexpr size_t WS_PD = 258 * MiB;
constexpr size_t WS_ACT = 294 * MiB;
constexpr size_t WS_SU = 3 * MiB;
constexpr size_t WS_END = 376 * MiB;
constexpr int CW_BAR = 4096;

constexpr int RING_BYTES = 131072, LDSCTL_OFF = 147456, MISC_OFF = LDSCTL_OFF + 320, LDS_BYTES = 148480;

#define GAS __attribute__((address_space(1)))
#define LAS __attribute__((address_space(3)))
typedef unsigned short bf16;
typedef unsigned v4u __attribute__((ext_vector_type(4)));
typedef unsigned v2u __attribute__((ext_vector_type(2)));
typedef float f32x4 __attribute__((ext_vector_type(4)));
typedef float f32x2 __attribute__((ext_vector_type(2)));
typedef short bf16x8 __attribute__((ext_vector_type(8)));
typedef __bf16 bf16x2 __attribute__((ext_vector_type(2)));
#define RLX_AGENT __ATOMIC_RELAXED, __HIP_MEMORY_SCOPE_AGENT
#define LDS_WAIT() asm volatile("s_waitcnt lgkmcnt(0)" ::: "memory")
__device__ __forceinline__ unsigned f2bf(float f) { unsigned u = __builtin_bit_cast(unsigned, f); return (u + 0x7fffu + ((u >> 16) & 1u)) >> 16; }
__device__ __forceinline__ unsigned pk2(float lo, float hi) { return pg8::cvt_pk_bf16(lo, hi); }
__device__ __forceinline__ float bflo(unsigned u) { return __builtin_bit_cast(float, u << 16); }
__device__ __forceinline__ float bfhi(unsigned u) { return __builtin_bit_cast(float, u & 0xffff0000u); }
__device__ __forceinline__ float dot2_bf16(unsigned w, unsigned x, float acc) { return __builtin_amdgcn_fdot2_f32_bf16(__builtin_bit_cast(bf16x2, w), __builtin_bit_cast(bf16x2, x), acc, false); }

#define XB_TMO      128
#define XB_XCNT(j)  (256  + 64 * (j))
#define XB_XSUB(j)  (1280 + 64 * (j))
#define XB_XGEN(j)  (2304 + 64 * (j))
#define XB_TOP      3328
#define XB_TOPGEN   3392
#define XCD_BAR_WORDS 3456
#define XB_SPIN_CAP (1u << 22)
__device__ __forceinline__ unsigned xb_ld(unsigned* p)              { return __hip_atomic_load(p, __ATOMIC_RELAXED, __HIP_MEMORY_SCOPE_AGENT); }
__device__ __forceinline__ unsigned xb_add(unsigned* p, unsigned v) { return __hip_atomic_fetch_add(p, v, __ATOMIC_RELAXED, __HIP_MEMORY_SCOPE_AGENT); }
__device__ __forceinline__ unsigned xb_xcc_id() { return (unsigned)__builtin_amdgcn_s_getreg((3 << 11) | 20) & 0xFu; }
#define XB_SPIN(cond, bar) do { unsigned _sp = 0; while (cond) { __builtin_amdgcn_s_sleep(1); \
    if ((++_sp & 255u) == 0u) { if (xb_ld(&(bar)[XB_TMO])) break; if (_sp > XB_SPIN_CAP) { atomicAdd(&(bar)[XB_TMO], 1u); break; } } } } while (0)
struct XcdBarrier { unsigned* bar; unsigned x; volatile LAS unsigned* st; };
__device__ __forceinline__ XcdBarrier xcd_barrier_post(unsigned* bar, volatile LAS unsigned* st) {
    XcdBarrier b; b.bar = bar; b.x = xb_xcc_id(); b.st = st;
    if (threadIdx.x == 0) (void)xb_add(&bar[XB_XCNT(b.x)], 1u);
    return b;
}
__device__ __forceinline__ void xcd_barrier_complete(unsigned* bar, unsigned x, unsigned& nloc, unsigned& nx) {
    const unsigned G = gridDim.x * gridDim.y * gridDim.z;
    unsigned sum, cnt, mine, sp = 0u;
    for (;;) {
        sum = 0u; cnt = 0u; mine = 0u;
#pragma unroll
        for (unsigned j = 0; j < 16; ++j) { const unsigned c = xb_ld(&bar[XB_XCNT(j)]); sum += c; cnt += (c > 0u) ? 1u : 0u; mine = (j == x) ? c : mine; }
        if (sum == G) break;
        __builtin_amdgcn_s_sleep(1);
        if ((++sp & 255u) == 0u) { if (xb_ld(&bar[XB_TMO])) break; if (sp > XB_SPIN_CAP) { atomicAdd(&bar[XB_TMO], 1u); break; } }
    }
    nloc = mine > 0u ? mine : 1u; nx = cnt > 0u ? cnt : 1u;
}
__device__ __forceinline__ void xcd_barrier(const XcdBarrier& b) {
    asm volatile("s_waitcnt vmcnt(0)" ::: "memory");
    __syncthreads();
    if (threadIdx.x == 0) {
        unsigned* bar = b.bar;
        __builtin_amdgcn_s_waitcnt(0);
        unsigned nloc = b.st[0], nx = b.st[1];
        if (nloc == 0u) { xcd_barrier_complete(bar, b.x, nloc, nx); b.st[0] = nloc; b.st[1] = nx; }
        const unsigned old = xb_add(&bar[XB_XSUB(b.x)], 1u);
        const unsigned gen = old / nloc;
        if (old + 1u == (gen + 1u) * nloc) {
            __builtin_amdgcn_fence(__ATOMIC_RELEASE, "agent");
            asm volatile("s_waitcnt vmcnt(0)" ::: "memory");
            const unsigned og = xb_add(&bar[XB_TOP], 1u);
            const unsigned tg = og / nx;
            if (og + 1u == (tg + 1u) * nx) xb_add(&bar[XB_TOPGEN], 1u);
            else XB_SPIN(xb_ld(&bar[XB_TOPGEN]) == tg, bar);
            __builtin_amdgcn_fence(__ATOMIC_ACQUIRE, "agent");
            xb_add(&bar[XB_XGEN(b.x)], 1u);
            asm volatile("s_waitcnt vmcnt(0)" ::: "memory");
        } else {
            XB_SPIN(xb_ld(&bar[XB_XGEN(b.x)]) == gen, bar);
            __builtin_amdgcn_fence(__ATOMIC_ACQUIRE, "agent");
            asm volatile("s_waitcnt vmcnt(0)" ::: "memory");
        }
    }
    __syncthreads();
}

typedef unsigned u32x2 __attribute__((ext_vector_type(2)));
template <int CTRL> __device__ __forceinline__ float dpp_f(float v) { return __builtin_bit_cast(float, __builtin_amdgcn_update_dpp(0, __builtin_bit_cast(int, v), CTRL, 0xf, 0xf, true)); }
__device__ __forceinline__ unsigned xmax16(unsigned m) { const u32x2 r = __builtin_amdgcn_permlane16_swap(m, m, false, false); return max(r[0], r[1]); }
__device__ __forceinline__ unsigned xmax32(unsigned m) { const u32x2 r = __builtin_amdgcn_permlane32_swap(m, m, false, false); return max(r[0], r[1]); }
__device__ __forceinline__ unsigned xor16(unsigned m) { const u32x2 r = __builtin_amdgcn_permlane16_swap(m, m, false, false); return r[0] | r[1]; }
__device__ __forceinline__ unsigned xor32(unsigned m) { const u32x2 r = __builtin_amdgcn_permlane32_swap(m, m, false, false); return r[0] | r[1]; }
template <int N> __device__ __forceinline__ float dpp_shr(float v) {
    return __builtin_bit_cast(float, __builtin_amdgcn_update_dpp(0, __builtin_bit_cast(int, v), 0x110 | N, 0xf, 0xf, true));
}
__device__ __forceinline__ float wave_sum(float v) {
    v += dpp_f<0xB1>(v); v += dpp_f<0x4E>(v); v += dpp_f<0x141>(v); v += dpp_f<0x140>(v);
    v += __builtin_bit_cast(float, __builtin_amdgcn_update_dpp(0, __builtin_bit_cast(int, v), 0x142, 0xa, 0xf, false));
    v += __builtin_bit_cast(float, __builtin_amdgcn_update_dpp(0, __builtin_bit_cast(int, v), 0x143, 0xc, 0xf, false));
    return __builtin_bit_cast(float, __builtin_amdgcn_readlane(__builtin_bit_cast(int, v), 63));
}
__device__ __forceinline__ float fast_rcp(float x) { return __builtin_amdgcn_rcpf(x); }
__device__ __forceinline__ float sigmoidf_(float x) { return fast_rcp(1.f + __expf(-x)); }
__device__ __forceinline__ float gelu_tanh(float x) { const float z = 1.5957691216057308f * (x + 0.044715f * x * x * x); return x * fast_rcp(1.f + __expf(-z)); }

struct Args { const float* in[28]; float* out; unsigned char* ws; int ph_lo, ph_hi; };

enum { I_XP = 0, I_XS, I_CP, I_CS, I_SLH, I_SLC, I_SSC, I_WADA, I_BADA, I_N1G, I_N2G, I_WIN, I_LCW, I_LCB, I_LWA, I_LBA, I_LWX, I_LBX, I_LAM, I_SCW, I_GLG, I_GSG, I_WOUT, I_WQ, I_KEYS, I_PU, I_PV, I_FG };

__device__ __forceinline__ void transpose_item(const float* W, int K, int N, bf16* WT, LAS float* scr, int item, int lane) {
    const int nblk = N / 32, kb = item / nblk, nb = item % nblk, k0 = 64 * kb, n0 = 32 * nb;
#pragma unroll 8
    for (int i = 0; i < 32; ++i) { const int kk = 2 * i + (lane >> 5); scr[kk * 33 + (lane & 31)] = __builtin_nontemporal_load(W + (size_t)(k0 + kk) * N + n0 + (lane & 31)); }
    LDS_WAIT(); asm volatile("" ::: "memory");
    const int c = lane & 7;
#pragma unroll
    for (int j = 0; j < 4; ++j) { const int n = (lane >> 3) + 8 * j; const LAS float* s = scr + (8 * c) * 33 + n;
        v4u o; o.x = pk2(s[0 * 33], s[1 * 33]); o.y = pk2(s[2 * 33], s[3 * 33]); o.z = pk2(s[4 * 33], s[5 * 33]); o.w = pk2(s[6 * 33], s[7 * 33]);
        *(v4u*)(WT + (size_t)(n0 + n) * K + k0 + 8 * c) = o; }
    LDS_WAIT(); asm volatile("" ::: "memory");
}

template <int CTRL> __device__ __forceinline__ unsigned dpp_u(unsigned v) { return (unsigned)__builtin_amdgcn_update_dpp(0, (int)v, CTRL, 0xf, 0xf, true); }
__device__ __forceinline__ float wave_max_pos(float v) {
    unsigned m = __builtin_bit_cast(unsigned, v);
    m = max(m, dpp_u<0xB1>(m)); m = max(m, dpp_u<0x4E>(m)); m = max(m, dpp_u<0x141>(m)); m = max(m, dpp_u<0x140>(m));
    m = xmax16(m); m = xmax32(m);
    return __builtin_bit_cast(float, m);
}
__device__ __forceinline__ void cvt_row_store(const f32x4 (&v)[8], float mx, unsigned char* dst, float* scales, int e, int lane) {
    const float q = mx > 0.f ? 224.f / mx : 1.f;
    if (lane == 0) scales[e] = mx > 0.f ? mx * (1.f / 224.f) : 1.f;
#pragma unroll
    for (int j = 0; j < 8; ++j) {
        int w = __builtin_amdgcn_cvt_pk_fp8_f32(v[j][0] * q, v[j][1] * q, 0, false);
        w = __builtin_amdgcn_cvt_pk_fp8_f32(v[j][2] * q, v[j][3] * q, w, true);
        const int sl = 2 * j + (lane >> 5);
        *(int*)(dst + ((size_t)sl * NEXP + e) * 128 + ((4 * lane) & 127)) = w;
    }
}
__device__ __forceinline__ void cvt_table_fp8(const float* src, unsigned char* dst, float* scales, int e_lo, int e_hi, int gw, int NGW, int lane) {
    for (int e = e_lo + gw; e < e_hi; e += 2 * NGW) {
        const int e2 = e + NGW < e_hi ? e + NGW : e;
        const float* r0 = src + (size_t)e * DM; const float* r1 = src + (size_t)e2 * DM;
        f32x4 v0[8], v1[8]; float m0 = 0.f, m1 = 0.f;
#pragma unroll
        for (int j = 0; j < 8; ++j) { v0[j] = __builtin_nontemporal_load((const f32x4*)(r0 + 4 * lane + 256 * j)); v1[j] = __builtin_nontemporal_load((const f32x4*)(r1 + 4 * lane + 256 * j)); }
#pragma unroll
        for (int j = 0; j < 8; ++j) { m0 = fmaxf(m0, fmaxf(fmaxf(fabsf(v0[j][0]), fabsf(v0[j][1])), fmaxf(fabsf(v0[j][2]), fabsf(v0[j][3]))));
                                      m1 = fmaxf(m1, fmaxf(fmaxf(fabsf(v1[j][0]), fabsf(v1[j][1])), fmaxf(fabsf(v1[j][2]), fabsf(v1[j][3])))); }
        m0 = wave_max_pos(m0); m1 = wave_max_pos(m1);
        cvt_row_store(v0, m0, dst, scales, e, lane);
        cvt_row_store(v1, m1, dst, scales, e2, lane);
    }
}

__device__ __forceinline__ void phase_convert(const Args& a, LAS unsigned char* lds, int vcu, int G, int wave, int lane, int tid) {
    unsigned char* ws = a.ws;
    const size_t gtid = (size_t)vcu * 512 + tid, nthr = (size_t)G * 512;
    { bf16* S = (bf16*)(ws + WS_S);
      for (size_t i = gtid; i < (size_t)144 * 2048 / 2; i += nthr) { const int row = (int)(i / 1024), col = (int)(i % 1024) * 2;
          float v0 = 0.f, v1 = 0.f;
          if (row < NMOD) { const float* c = row < 4 ? a.in[I_CP] + (size_t)row * 2048 : a.in[I_CS] + (size_t)(row - 4) * 2048; const float c0 = c[col], c1 = c[col + 1]; v0 = c0 * sigmoidf_(c0); v1 = c1 * sigmoidf_(c1); }
          *(unsigned*)(S + (size_t)row * 2048 + col) = pk2(v0, v1); } }
    { bf16* WAT = (bf16*)(ws + WS_WAT); bf16* WXT = WAT + 65536; bf16* KB = WAT + 131072;
      for (size_t i = gtid; i < 65536; i += nthr) { const int h = (int)(i >> 12), j = (int)(i >> 6) & 63, ii = (int)i & 63;
          WAT[i] = (bf16)f2bf(a.in[I_LWA][(size_t)h * 4096 + ii * 64 + j]); WXT[i] = (bf16)f2bf(a.in[I_LWX][(size_t)h * 4096 + ii * 64 + j]); }
      for (size_t i = gtid; i < 32768; i += nthr) KB[i] = (bf16)f2bf(a.in[I_KEYS][i]); }
    { LAS float* scr = (LAS float*)(lds + wave * 16384);
      const int gw = vcu * NWAVES + wave, NGW = G * NWAVES;
      constexpr int I_IN = (DM / 64) * (INC / 32), I_O = (DM / 64) * (DM / 32);
      for (int it = gw; it < I_IN + 2 * I_O; it += NGW) {
          int r = it;
          if (r < I_IN) { transpose_item(a.in[I_WIN], DM, INC, (bf16*)(ws + WS_WIN), scr, r, lane); continue; } r -= I_IN;
          if (r < I_O) { transpose_item(a.in[I_WOUT], DM, DM, (bf16*)(ws + WS_WOUT), scr, r, lane); continue; } r -= I_O;
          transpose_item(a.in[I_WQ], DM, DM, (bf16*)(ws + WS_WQ), scr, r, lane);
      } }

}

__device__ __forceinline__ void adaln_load(const float* W, int n0, int kc, int tid, f32x4 (&r)[3]) {
#pragma unroll
    for (int j = 0; j < 3; ++j) { const int i = tid + 512 * j; const int row = i / 12, c4 = i - row * 12; r[j] = __builtin_nontemporal_load((const f32x4*)(W + (size_t)(kc * 128 + row) * MODW + n0 + 4 * c4)); }
}
__device__ __forceinline__ void adaln_stage(LAS unsigned char* buf, int tid, const f32x4 (&r)[3]) {
#pragma unroll
    for (int j = 0; j < 3; ++j) { const int i = tid + 512 * j; const int row = i / 12, c4 = i - row * 12;
#pragma unroll
        for (int e = 0; e < 4; ++e) *(LAS bf16*)(buf + (4 * c4 + e) * 272 + row * 2) = (bf16)f2bf(r[j][e]); }
}
__device__ __forceinline__ void adaln_compute(const bf16* S, LAS unsigned char* buf, int kc, int wave, int fr, int fq, f32x4 (&acc)[2][3]) {
#pragma unroll
    for (int ks = 0; ks < 4; ++ks) {
        bf16x8 bfr[3];
#pragma unroll
        for (int n = 0; n < 3; ++n) bfr[n] = *(const LAS bf16x8*)(buf + (16 * n + fr) * 272 + (32 * ks + 8 * fq) * 2);
        { const bf16x8 af = *(const bf16x8*)(S + (size_t)(16 * wave + fr) * 2048 + kc * 128 + 32 * ks + 8 * fq);
#pragma unroll
          for (int n = 0; n < 3; ++n) acc[0][n] = __builtin_amdgcn_mfma_f32_16x16x32_bf16(af, bfr[n], acc[0][n], 0, 0, 0); }
        if (wave == 0) { const bf16x8 af = *(const bf16x8*)(S + (size_t)(128 + fr) * 2048 + kc * 128 + 32 * ks + 8 * fq);
#pragma unroll
          for (int n = 0; n < 3; ++n) acc[1][n] = __builtin_amdgcn_mfma_f32_16x16x32_bf16(af, bfr[n], acc[1][n], 0, 0, 0); }
    }
}
__device__ __forceinline__ void phase_adaln(const Args& a, LAS unsigned char* lds, int G, int wave, int lane, int tid) {
    const bf16* S = (const bf16*)(a.ws + WS_S); const float* W = a.in[I_WADA]; float* MOD = (float*)(a.ws + WS_MOD);
    const int fr = lane & 15, fq = lane >> 4;
    LAS unsigned char* buf0 = lds; LAS unsigned char* buf1 = lds + 16384;
    for (int item = blockIdx.x; item < MODW / 48; item += G) {
        const int n0 = item * 48;
        f32x4 acc[2][3];
#pragma unroll
        for (int m = 0; m < 2; ++m)
#pragma unroll
            for (int n = 0; n < 3; ++n) acc[m][n] = (f32x4){0.f, 0.f, 0.f, 0.f};
        f32x4 ra[3], rb[3], rc[3], rd[3];
        adaln_load(W, n0, 0, tid, ra); adaln_load(W, n0, 1, tid, rb); adaln_load(W, n0, 2, tid, rc); adaln_load(W, n0, 3, tid, rd);
#pragma unroll 1
        for (int c = 0; c < 16; c += 4) {
            adaln_stage(buf0, tid, ra); if (c + 4 < 16) adaln_load(W, n0, c + 4, tid, ra);
            __syncthreads();
            adaln_compute(S, buf0, c, wave, fr, fq, acc);
            adaln_stage(buf1, tid, rb); if (c + 5 < 16) adaln_load(W, n0, c + 5, tid, rb);
            __syncthreads();
            adaln_compute(S, buf1, c + 1, wave, fr, fq, acc);
            adaln_stage(buf0, tid, rc); if (c + 6 < 16) adaln_load(W, n0, c + 6, tid, rc);
            __syncthreads();
            adaln_compute(S, buf0, c + 2, wave, fr, fq, acc);
            adaln_stage(buf1, tid, rd); if (c + 7 < 16) adaln_load(W, n0, c + 7, tid, rd);
            __syncthreads();
            adaln_compute(S, buf1, c + 3, wave, fr, fq, acc);
        }
#pragma unroll
        for (int mi = 0; mi < 2; ++mi) { if (mi == 1 && wave != 0) break; const int m = mi == 0 ? wave : 8;
#pragma unroll
            for (int n = 0; n < 3; ++n)
#pragma unroll
                for (int r = 0; r < 4; ++r) { const int b = 16 * m + 4 * fq + r, col = n0 + 16 * n + fr; if (b < NMOD) MOD[(size_t)b * MODW + col] = acc[mi][n][r] + a.in[I_BADA][col]; } }
        __syncthreads();
    }
}

__device__ __forceinline__ f32x4 ld_bf4(const bf16* p) { const v2u u = *(const v2u*)p; return (f32x4){bflo(u.x), bfhi(u.x), bflo(u.y), bfhi(u.y)}; }
__device__ __forceinline__ void phase_normmod(const Args& a, int which, int gw, int NGW, int lane, int row_lo, int row_hi) {
    const float* MOD = (const float*)(a.ws + WS_MOD); bf16* H = (bf16*)(a.ws + WS_HBUF);
    const float* g = a.in[which ? I_N2G : I_N1G];
    v2u pend[8]; f32x4 pendx[8]; int prow = -1;
    for (int row = row_lo + gw; row < row_hi; row += NGW) {
        const float* xr = row < NPROMPT ? a.in[I_XP] + (size_t)row * DM : a.in[I_XS] + (size_t)(row - NPROMPT) * DM;
        const int mb = row < NPROMPT ? (row >> 11) : 4 + ((row - NPROMPT) >> 3);
        const float* sh = MOD + (size_t)mb * MODW + (which ? 3 : 0) * DM; const float* sc = sh + DM;
        f32x4 v[8], gv[8], sv[8], hv[8], mx[8], g1[8];
#pragma unroll
        for (int j = 0; j < 8; ++j) { const int c = 4 * lane + 256 * j; v[j] = which ? __builtin_nontemporal_load((const f32x4*)(xr + c)) : *(const f32x4*)(xr + c); gv[j] = *(const f32x4*)(g + c); sv[j] = *(const f32x4*)(sc + c); hv[j] = *(const f32x4*)(sh + c);
            if (which) { mx[j] = ld_bf4((const bf16*)(a.ws + WS_Q) + (size_t)row * DM + c); g1[j] = *(const f32x4*)(MOD + (size_t)mb * MODW + 2 * DM + c); } }
        __builtin_amdgcn_sched_barrier(0);
        if (prow >= 0) {
#pragma unroll
            for (int j = 0; j < 8; ++j) { const int c = 4 * lane + 256 * j; *(v2u*)(H + (size_t)prow * DM + c) = pend[j]; }
        }
        __builtin_amdgcn_sched_barrier(0);
        float ss = 0.f;
#pragma unroll
        for (int j = 0; j < 8; ++j) { if (which) { v[j] = v[j] + g1[j] * mx[j]; pendx[j] = v[j]; }
            ss += (v[j][0] * v[j][0] + v[j][1] * v[j][1]) + (v[j][2] * v[j][2] + v[j][3] * v[j][3]); }
        const float rstd = rsqrtf(wave_sum(ss) * (1.f / DM) + EPS);
#pragma unroll
        for (int j = 0; j < 8; ++j) { const f32x4 o = (v[j] * rstd) * gv[j] * (sv[j] + 1.f) + hv[j]; pend[j].x = pk2(o[0], o[1]); pend[j].y = pk2(o[2], o[3]); }
        prow = row;
    }
    if (prow >= 0) {
#pragma unroll
        for (int j = 0; j < 8; ++j) { const int c = 4 * lane + 256 * j; *(v2u*)(H + (size_t)prow * DM + c) = pend[j]; }
    }
}

template <bool PROMPT>
__device__ __forceinline__ f32x4 xlru4(const bf16* PROJ, const float* stc, int r, int s, int d, int ch) {
    const bool inseq = s >= d;
    const f32x4 v = ld_bf4(PROJ + (size_t)(inseq ? r - d : r) * INC + ch);
    f32x4 h = (f32x4){0.f, 0.f, 0.f, 0.f};
    if constexpr (!PROMPT) { const int bs = (r - NPROMPT) >> 3; const int hi = inseq ? 0 : (3 + s - d); h = *(const f32x4*)(stc + ((size_t)bs * 3 + hi) * LW + ch); }
    f32x4 o;
#pragma unroll
    for (int i = 0; i < 4; ++i) o[i] = inseq ? v[i] : h[i];
    return o;
}
template <bool PROMPT>
__device__ __forceinline__ f32x4 conv4(const bf16* PROJ, const float* stc, const float* cw, const float* cb, int r, int s, int ch) {
    f32x4 o = *(const f32x4*)(cb + ch);
#pragma unroll
    for (int k = 0; k < 4; ++k) o += *(const f32x4*)(cw + k * LW + ch) * xlru4<PROMPT>(PROJ, stc, r, s, 3 - k, ch);
    return o;
}

template <bool PROMPT>
__device__ __forceinline__ void lru_fill(const Args& a, LAS unsigned char* wl, int T, int hd, int lane) {
    const bf16* PROJ = (const bf16*)(a.ws + WS_PROJ); const float* stc = a.in[I_SLC];
    const int r0 = 64 * T;
    if constexpr (PROMPT) {
        const bool has_hist = (r0 & 2047) != 0;
        for (int i = lane; i < 67 * 8; i += 64) { const int lr = i >> 3, c = i & 7;
            v4u v = (v4u){0u, 0u, 0u, 0u};
            if (lr >= 3 || has_hist) v = *(const v4u*)(PROJ + (size_t)(r0 - 3 + lr) * INC + hd * 64 + c * 8);
            *(LAS v4u*)(wl + lr * 144 + c * 16) = v; }
    } else {
        for (int i = lane; i < 88 * 8; i += 64) { const int lr = i >> 3, c = i & 7; const int k = lr / 11, j = lr - 11 * k;
            const int bs = ((r0 - NPROMPT) >> 3) + k; v4u v;
            if (j < 3) { const float* sp = stc + ((size_t)bs * 3 + j) * LW + hd * 64 + c * 8; const f32x4 f0 = *(const f32x4*)sp, f1 = *(const f32x4*)(sp + 4);
                         v.x = pk2(f0[0], f0[1]); v.y = pk2(f0[2], f0[3]); v.z = pk2(f1[0], f1[1]); v.w = pk2(f1[2], f1[3]); }
            else v = *(const v4u*)(PROJ + (size_t)(r0 + 8 * k + (j - 3)) * INC + hd * 64 + c * 8);
            *(LAS v4u*)(wl + lr * 144 + c * 16) = v; }
    }
}
template <bool PROMPT> __device__ __forceinline__ int lru_lrow(int rl) { return PROMPT ? 3 + rl : (rl >> 3) * 11 + 3 + (rl & 7); }
__device__ __forceinline__ f32x4 conv4l(const LAS unsigned char* wl, const float* cw, const float* cb, int lrow, int chl, int ch) {
    f32x4 o = *(const f32x4*)(cb + ch);
#pragma unroll
    for (int k = 0; k < 4; ++k) { const v2u u = *(const LAS v2u*)(wl + (lrow - 3 + k) * 144 + chl * 2);
        o += *(const f32x4*)(cw + k * LW + ch) * (f32x4){bflo(u.x), bfhi(u.x), bflo(u.y), bfhi(u.y)}; }
    return o;
}
__device__ __forceinline__ f32x4 conv4r(const LAS unsigned char* wl, const f32x4 (&w)[4], const f32x4 b, int lrow, int chl) {
    f32x4 o = b;
#pragma unroll
    for (int k = 0; k < 4; ++k) { const v2u u = *(const LAS v2u*)(wl + (lrow - 3 + k) * 144 + chl * 2); o += w[k] * (f32x4){bflo(u.x), bfhi(u.x), bflo(u.y), bfhi(u.y)}; }
    return o;
}
template <bool PROMPT>
__device__ __forceinline__ void lru_item(const Args& a, LAS unsigned char* wl, int T, int hd, int lane, int ot0, int ot1) {
    const bf16* PROJ = (const bf16*)(a.ws + WS_PROJ); const bf16* WAT = (const bf16*)(a.ws + WS_WAT); const bf16* WXT = WAT + 65536;
    bf16* HLOC = (bf16*)(a.ws + WS_HLOC); bf16* PCUM = (bf16*)(a.ws + WS_PCUM); float* ENDS = (float*)(a.ws + WS_ENDS);
    const float* stc = a.in[I_SLC]; const float* cw = a.in[I_LCW]; const float* cb = a.in[I_LCB];
    const int fr = lane & 15, fq = lane >> 4;
    {
        constexpr bool prompt = PROMPT;
        lru_fill<PROMPT>(a, wl, T, hd, lane);
        bf16x8 bfr[4][2];
#pragma unroll
        for (int jt = 0; jt < 4; ++jt) {
            const int row = 64 * T + 16 * jt + fr; const int s = prompt ? (row & 2047) : (row & 7);
#pragma unroll
            for (int ks = 0; ks < 2; ++ks) { const int ch = hd * 64 + 32 * ks + 8 * fq;
                const int lrw = lru_lrow<PROMPT>(16 * jt + fr); const f32x4 x0 = conv4l(wl, cw, cb, lrw, 32 * ks + 8 * fq, ch), x1 = conv4l(wl, cw, cb, lrw, 32 * ks + 8 * fq + 4, ch + 4);
                v4u p; p.x = pk2(x0[0], x0[1]); p.y = pk2(x0[2], x0[3]); p.z = pk2(x1[0], x1[1]); p.w = pk2(x1[2], x1[3]); bfr[jt][ks] = __builtin_bit_cast(bf16x8, p); }
            __builtin_amdgcn_sched_barrier(0);
        }
#pragma unroll 1
        for (int ot = ot0; ot < ot1; ++ot) {
            const int ch = hd * 64 + 16 * ot + 4 * fq;
            bf16x8 wa[2], wx[2];
#pragma unroll
            for (int ks = 0; ks < 2; ++ks) { const size_t wo = ((size_t)(hd * 64 + 16 * ot + fr)) * 64 + 32 * ks + 8 * fq; wa[ks] = *(const bf16x8*)(WAT + wo); wx[ks] = *(const bf16x8*)(WXT + wo); }
            const f32x4 ba = *(const f32x4*)(a.in[I_LBA] + ch), bx = *(const f32x4*)(a.in[I_LBX] + ch), lam = *(const f32x4*)(a.in[I_LAM] + ch);
            f32x4 sp8;
#pragma unroll
            for (int r = 0; r < 4; ++r) { const float nl = -lam[r]; sp8[r] = -8.f * (fmaxf(nl, 0.f) + log1pf(__expf(-fabsf(nl)))); }
            f32x4 Pc = (f32x4){1.f, 1.f, 1.f, 1.f}, Hc = (f32x4){0.f, 0.f, 0.f, 0.f};
            f32x4 cwv[4]; const f32x4 cbv = *(const f32x4*)(cb + ch);
#pragma unroll
            for (int k = 0; k < 4; ++k) cwv[k] = *(const f32x4*)(cw + k * LW + ch);
            f32x4 h0v[4];
#pragma unroll
            for (int jt = 0; jt < 4; ++jt) { h0v[jt] = (f32x4){0.f, 0.f, 0.f, 0.f};
                if constexpr (!PROMPT) { const int bs0 = (64 * T + 16 * jt + fr - NPROMPT) >> 3; h0v[jt] = *(const f32x4*)(a.in[I_SLH] + (size_t)bs0 * LW + ch); } }
#pragma unroll
            for (int jt = 0; jt < 4; ++jt) {
                const int row = 64 * T + 16 * jt + fr; const int s = prompt ? (row & 2047) : (row & 7);
                f32x4 accA = (f32x4){0.f, 0.f, 0.f, 0.f}, accX = accA;
#pragma unroll
                for (int ks = 0; ks < 2; ++ks) {
                    accA = __builtin_amdgcn_mfma_f32_16x16x32_bf16(wa[ks], bfr[jt][ks], accA, 0, 0, 0);
                    accX = __builtin_amdgcn_mfma_f32_16x16x32_bf16(wx[ks], bfr[jt][ks], accX, 0, 0, 0); }
                const f32x4 xin = conv4r(wl, cwv, cbv, lru_lrow<PROMPT>(16 * jt + fr), 16 * ot + 4 * fq);
                f32x4 av, uv;
#pragma unroll
                for (int r = 0; r < 4; ++r) {
                    const float ra = sigmoidf_(accA[r] + ba[r]), ii = sigmoidf_(accX[r] + bx[r]);
                    const float la = sp8[r] * ra;
                    const float z = 2.f * la;
                    const float em = z > -0.1f ? -z * (1.f + z * (0.5f + z * (0.16666667f + z * 0.041666667f))) : 1.f - __expf(z);
                    av[r] = __expf(la); uv[r] = __builtin_amdgcn_sqrtf(em) * (ii * xin[r]);
                }
#pragma unroll
                for (int r = 0; r < 4; ++r) {
                    float A = av[r], U = uv[r];
                    { const float ap = dpp_shr<1>(A), up = dpp_shr<1>(U); if (prompt ? (fr >= 1) : ((fr & 7) >= 1)) { U = A * up + U; A = A * ap; } }
                    { const float ap = dpp_shr<2>(A), up = dpp_shr<2>(U); if (prompt ? (fr >= 2) : ((fr & 7) >= 2)) { U = A * up + U; A = A * ap; } }
                    { const float ap = dpp_shr<4>(A), up = dpp_shr<4>(U); if (prompt ? (fr >= 4) : ((fr & 7) >= 4)) { U = A * up + U; A = A * ap; } }
                    { const float ap = dpp_shr<8>(A), up = dpp_shr<8>(U); if (prompt && fr >= 8) { U = A * up + U; A = A * ap; } }
                    av[r] = A; uv[r] = U;
                }
                f32x4 hv, pv;
                if (prompt) {
#pragma unroll
                    for (int r = 0; r < 4; ++r) { hv[r] = uv[r] + av[r] * Hc[r]; pv[r] = av[r] * Pc[r]; }
#pragma unroll
                    for (int r = 0; r < 4; ++r) { Hc[r] = __shfl(hv[r], 15, 16); Pc[r] = __shfl(pv[r], 15, 16); }
                    if (jt == 3 && fr == 15) {
                        float* e = ENDS + ((size_t)T * LW + ch) * 2;
                        *(f32x4*)e = (f32x4){pv[0], hv[0], pv[1], hv[1]}; *(f32x4*)(e + 4) = (f32x4){pv[2], hv[2], pv[3], hv[3]};
                    }
                } else {
                    const int bs = (row - NPROMPT) >> 3;
#pragma unroll
                    for (int r = 0; r < 4; ++r) { hv[r] = uv[r] + av[r] * h0v[jt][r]; pv[r] = 0.f; }
                    if ((row & 7) == 7) *(f32x4*)(a.out + O_HS + (size_t)bs * LW + ch) = hv;
                }
                { v4u hp4; hp4.x = pk2(hv[0], hv[1]); hp4.y = pk2(hv[2], hv[3]); hp4.z = pk2(pv[0], pv[1]); hp4.w = pk2(pv[2], pv[3]);
                  *(v4u*)(HLOC + ((size_t)row * LW + ch) * 2) = hp4; }
                __builtin_amdgcn_sched_barrier(0);
            }
        }
    }
}

__device__ __forceinline__ void phase_lru(const Args& a, LAS unsigned char* lds, int vcu, int G, int wave, int lane) {
    const int gw = vcu * NWAVES + wave, NGW = G * NWAVES;
    LAS unsigned char* wl = lds + wave * 16384;
    if (G * 9 == 144 * 16) {
        { const int item = vcu * 9 + wave; const int T = item >> 4, hd = item & 15;
          if (T < 128) lru_item<true>(a, wl, T, hd, lane, 0, 4); else lru_item<false>(a, wl, T, hd, lane, 0, 4); }
        if (wave < 4) { const int item = vcu * 9 + 8; const int T = item >> 4, hd = item & 15;
          if (T < 128) lru_item<true>(a, wl, T, hd, lane, wave, wave + 1); else lru_item<false>(a, wl, T, hd, lane, wave, wave + 1); }
        return;
    }
    for (int item = gw; item < 144 * 16; item += NGW) {
        const int T = item >> 4, hd = item & 15;
        if (T < 128) lru_item<true>(a, wl, T, hd, lane, 0, 4); else lru_item<false>(a, wl, T, hd, lane, 0, 4);
    }
}

template <bool PROMPT>
__device__ __forceinline__ f32x4 cx4(const bf16* PROJ, const float* sts, int r, int s, int d, int ch) {
    const bool inseq = s >= d;
    const bf16* p = PROJ + (size_t)(inseq ? r - d : r) * INC;
    const f32x4 v = ld_bf4(p + 3072 + ch) * ld_bf4(p + 4096 + ch);
    f32x4 h = (f32x4){0.f, 0.f, 0.f, 0.f};
    if constexpr (!PROMPT) { const int bs = (r - NPROMPT) >> 3; const int hi = inseq ? 0 : (2 + s - d); h = *(const f32x4*)(sts + ((size_t)bs * 2 + hi) * LW + ch); }
    f32x4 o;
#pragma unroll
    for (int i = 0; i < 4; ++i) o[i] = inseq ? v[i] : h[i];
    return o;
}
__device__ __forceinline__ void ld_bf8(const bf16* p, f32x4& lo, f32x4& hi) { const v4u u = *(const v4u*)p; lo = (f32x4){bflo(u.x), bfhi(u.x), bflo(u.y), bfhi(u.y)}; hi = (f32x4){bflo(u.z), bfhi(u.z), bflo(u.w), bfhi(u.w)}; }
template <bool PROMPT>
__device__ __forceinline__ void cx8(const bf16* PROJ, const float* sts, int r, int s, int d, int ch, f32x4& lo, f32x4& hi) {
    const bool inseq = s >= d;
    const bf16* p = PROJ + (size_t)(inseq ? r - d : r) * INC;
    f32x4 cl, chh, xl, xh; ld_bf8(p + 3072 + ch, cl, chh); ld_bf8(p + 4096 + ch, xl, xh);
    f32x4 hl = (f32x4){0.f, 0.f, 0.f, 0.f}, hh = hl;
    if constexpr (!PROMPT) { const int bs = (r - NPROMPT) >> 3; const int hi_ = inseq ? 0 : (2 + s - d); const float* sp = sts + ((size_t)bs * 2 + hi_) * LW + ch; hl = *(const f32x4*)sp; hh = *(const f32x4*)(sp + 4); }
#pragma unroll
    for (int i = 0; i < 4; ++i) { lo[i] = inseq ? cl[i] * xl[i] : hl[i]; hi[i] = inseq ? chh[i] * xh[i] : hh[i]; }
}
template <bool PROMPT>
__device__ __forceinline__ void mix_row(const Args& a, const bf16* PROJ, bf16* H, const bf16* HLOC, const bf16* PCUM, LAS float* carry, const float* sts, const float* scw, int row, int lane) {
    constexpr bool prompt = PROMPT;
        const int s = prompt ? (row & 2047) : (row & 7); const int S = prompt ? 2048 : 8;
        const int bidx = prompt ? (row >> 11) : ((row - NPROMPT) >> 3);
        float* o_h = a.out + (prompt ? O_HP : O_HS) + (size_t)bidx * LW;
        float* o_lc = a.out + (prompt ? O_LCP : O_LCS) + ((size_t)bidx * 3 + (s - (S - 3))) * LW;
        float* o_sc = a.out + (prompt ? O_SCP : O_SCS) + ((size_t)bidx * 2 + (s - (S - 2))) * LW;
        const bf16* pr = PROJ + (size_t)row * INC;
        f32x4 ol[4], os[4]; float ssl = 0.f, sss = 0.f;
#pragma unroll
        for (int j = 0; j < 2; ++j) { const int ch8 = 8 * lane + 512 * j;
            f32x4 hl[2], pc[2], yg[2], sb[2], xl[2], c2[2], c1[2], c0[2];
            ld_bf8(HLOC + ((size_t)row * LW + ch8) * 2, hl[0], pc[0]); ld_bf8(HLOC + ((size_t)row * LW + ch8) * 2 + 8, hl[1], pc[1]);
            ld_bf8(pr + 1024 + ch8, yg[0], yg[1]); ld_bf8(pr + 2048 + ch8, sb[0], sb[1]);
            if (s >= S - 3) ld_bf8(pr + ch8, xl[0], xl[1]);
            cx8<PROMPT>(PROJ, sts, row, s, 2, ch8, c2[0], c2[1]); cx8<PROMPT>(PROJ, sts, row, s, 1, ch8, c1[0], c1[1]); cx8<PROMPT>(PROJ, sts, row, s, 0, ch8, c0[0], c0[1]);
#pragma unroll
            for (int hh = 0; hh < 2; ++hh) { const int ch = ch8 + 4 * hh;
                const f32x4 cr = *(const LAS f32x4*)(carry + ch);
                const f32x4 h = hl[hh] + pc[hh] * cr;
                f32x4 o;
#pragma unroll
                for (int r = 0; r < 4; ++r) o[r] = h[r] * gelu_tanh(yg[hh][r]);
                ol[2 * j + hh] = o; ssl += (o[0] * o[0] + o[1] * o[1]) + (o[2] * o[2] + o[3] * o[3]);
                if (prompt && s == S - 1) {
                    const float* e = (const float*)(a.ws + WS_ENDS) + ((size_t)(row >> 6) * LW + ch) * 2;
                    const f32x4 e0 = *(const f32x4*)e, e1 = *(const f32x4*)(e + 4);
                    *(f32x4*)(o_h + ch) = (f32x4){e0[1] + e0[0] * cr[0], e0[3] + e0[2] * cr[1], e1[1] + e1[0] * cr[2], e1[3] + e1[2] * cr[3]}; }
                if (s >= S - 3) *(f32x4*)(o_lc + ch) = xl[hh];
                const f32x4 cv = *(const f32x4*)(scw + ch) * c2[hh] + *(const f32x4*)(scw + LW + ch) * c1[hh] + *(const f32x4*)(scw + 2 * LW + ch) * c0[hh];
                const f32x4 q = sb[hh] * cv;
                os[2 * j + hh] = q; sss += (q[0] * q[0] + q[1] * q[1]) + (q[2] * q[2] + q[3] * q[3]);
                if (s >= S - 2) *(f32x4*)(o_sc + ch) = c0[hh];
            }
        }
        const float rl = rsqrtf(wave_sum(ssl) * (1.f / LW) + EPS), rs = rsqrtf(wave_sum(sss) * (1.f / LW) + EPS);
#pragma unroll
        for (int j = 0; j < 2; ++j) { const int ch8 = 8 * lane + 512 * j;
            v4u p, q;
#pragma unroll
            for (int hh = 0; hh < 2; ++hh) { const int ch = ch8 + 4 * hh;
                const f32x4 gl = *(const f32x4*)(a.in[I_GLG] + ch), gs = *(const f32x4*)(a.in[I_GSG] + ch);
                const f32x4 x = ol[2 * j + hh] * rl * gl, y = os[2 * j + hh] * rs * gs;
                if (hh == 0) { p.x = pk2(x[0], x[1]); p.y = pk2(x[2], x[3]); q.x = pk2(y[0], y[1]); q.y = pk2(y[2], y[3]); }
                else { p.z = pk2(x[0], x[1]); p.w = pk2(x[2], x[3]); q.z = pk2(y[0], y[1]); q.w = pk2(y[2], y[3]); } }
            *(v4u*)(H + (size_t)row * DM + ch8) = p; *(v4u*)(H + (size_t)row * DM + LW + ch8) = q; }
}
__device__ __forceinline__ void phase_mix(const Args& a, LAS unsigned char* lds, int G, int vcu, int wave, int lane, int tid) {
    const bf16* PROJ = (const bf16*)(a.ws + WS_PROJ); bf16* H = (bf16*)(a.ws + WS_HBUF);
    const bf16* HLOC = (const bf16*)(a.ws + WS_HLOC); const bf16* PCUM = (const bf16*)(a.ws + WS_PCUM); const float* ENDS = (const float*)(a.ws + WS_ENDS);
    LAS float* carry = (LAS float*)lds;
    const float* sts = a.in[I_SSC]; const float* scw = a.in[I_SCW];
    for (int item = vcu; item < NTOK / 16; item += G) {
        const int R0 = item * 16, T = R0 >> 6; const bool prompt = T < 128; const int m = prompt ? (T & 31) : 0;
        { float c0 = 0.f, c1 = 0.f;
#pragma unroll 1
          for (int jb = T - m; jb < T; jb += 8) {
              f32x4 e[8];
#pragma unroll
              for (int u = 0; u < 8; ++u) e[u] = (jb + u < T) ? *(const f32x4*)(ENDS + ((size_t)(jb + u) * LW + 2 * tid) * 2) : (f32x4){1.f, 0.f, 1.f, 0.f};
#pragma unroll
              for (int u = 0; u < 8; ++u) { c0 = e[u][1] + e[u][0] * c0; c1 = e[u][3] + e[u][2] * c1; }
          }
          carry[2 * tid] = c0; carry[2 * tid + 1] = c1; }
        __syncthreads();
#pragma unroll 1
        for (int r2 = 0; r2 < 2; ++r2) {
        if (prompt) mix_row<true>(a, PROJ, H, HLOC, PCUM, carry, sts, scw, R0 + 8 * r2 + wave, lane); else mix_row<false>(a, PROJ, H, HLOC, PCUM, carry, sts, scw, R0 + 8 * r2 + wave, lane);
        }
        __syncthreads();
    }
}

__device__ __forceinline__ unsigned ordf(float f) { const unsigned u = __builtin_bit_cast(unsigned, f); return (u & 0x80000000u) ? ~u : (u | 0x80000000u); }
__device__ __forceinline__ float unordf(unsigned k) { const unsigned u = (k & 0x80000000u) ? (k & 0x7fffffffu) : ~k; return __builtin_bit_cast(float, u); }
__device__ __forceinline__ unsigned umax3(unsigned a, unsigned b, unsigned c) { return max(max(a, b), c); }

__device__ __forceinline__ void phase_topk(const Args& a, LAS unsigned char* lds, int gw, int NGW, int lane, int tid) {
    const bf16* Q = (const bf16*)(a.ws + WS_HLOC); const bf16* KB = (const bf16*)(a.ws + WS_WAT) + 131072;
    for (int i = tid; i < 256 * 16; i += NWAVES * 64) { const int r = i >> 4, c = i & 15; *(LAS v4u*)(lds + r * 272 + c * 16) = *(const v4u*)(KB + (size_t)r * 128 + c * 8); }
    __syncthreads();
    int* EIDX = (int*)(a.ws + WS_EIDX); float* GW = (float*)(a.ws + WS_GW);
    const int fr = lane & 15, fq = lane >> 4;
    for (int item = gw; item < (NTOK / 16) * 8; item += NGW) {
        const int tt = item >> 3, hd = item & 7; const int t = 16 * tt + fr;
        unsigned kk[2][16];
#pragma unroll
        for (int p = 0; p < 2; ++p) {
            f32x4 acc[8];
#pragma unroll
            for (int n = 0; n < 8; ++n) acc[n] = (f32x4){0.f, 0.f, 0.f, 0.f};
            bf16x8 qf[4];
            const unsigned qoff = (unsigned)t * (DM * 2) + (unsigned)fq * 16u, koff = (unsigned)fr * 272u + (unsigned)fq * 16u;
#pragma unroll
            for (int ks = 0; ks < 4; ++ks) qf[ks] = *(const bf16x8*)((const char*)Q + (size_t)((hd * 256 + p * 128 + 32 * ks) * 2) + qoff);
#pragma unroll
            for (int n = 0; n < 8; ++n) {
#pragma unroll
                for (int ks = 0; ks < 4; ++ks) acc[n] = __builtin_amdgcn_mfma_f32_16x16x32_bf16(*(const LAS bf16x8*)(lds + (p * 128 + 16 * n) * 272 + ks * 64 + koff), qf[ks], acc[n], 0, 0, 0);
                if (n & 1) __builtin_amdgcn_sched_barrier(0);
            }
            unsigned key[32];
#pragma unroll
            for (int n = 0; n < 8; ++n)
#pragma unroll
                for (int r = 0; r < 4; ++r) key[n * 4 + r] = (ordf(acc[n][r]) & ~0x7Fu) | (unsigned)(127 - (16 * n + 4 * fq + r));
#pragma unroll
            for (int k = 2; k <= 32; k <<= 1)
#pragma unroll
                for (int j = k >> 1; j > 0; j >>= 1)
#pragma unroll
                    for (int i = 0; i < 32; ++i) { const int l = i ^ j;
                        if (l > i) { const unsigned hi = max(key[i], key[l]), lo = min(key[i], key[l]); const bool desc = (i & k) == 0; key[i] = desc ? hi : lo; key[l] = desc ? lo : hi; } }
            unsigned tk[16];
#pragma unroll
            for (int i = 0; i < 16; ++i) tk[i] = key[i];
#pragma unroll
            for (int st = 0; st < 2; ++st) {
                unsigned oth[16];
#pragma unroll
                for (int i = 0; i < 16; ++i) oth[i] = st == 0 ? (unsigned)__builtin_amdgcn_ds_swizzle((int)tk[i], 0x401F) : (unsigned)__shfl_xor((int)tk[i], 32);
#pragma unroll
                for (int i = 0; i < 16; ++i) tk[i] = max(tk[i], oth[15 - i]);
#pragma unroll
                for (int j = 8; j > 0; j >>= 1)
#pragma unroll
                    for (int i = 0; i < 16; ++i) { const int l = i ^ j; if (l > i) { const unsigned hi = max(tk[i], tk[l]), lo = min(tk[i], tk[l]); tk[i] = hi; tk[l] = lo; } }
            }
#pragma unroll
            for (int i = 0; i < 16; ++i) kk[p][i] = tk[i];
        }
        float rv[4]; int rn[4];
#pragma unroll
        for (int k = 0; k < 4; ++k) {
            const unsigned s0 = kk[0][4 * k], s1 = kk[0][4 * k + 1], s2 = kk[0][4 * k + 2], s3 = kk[0][4 * k + 3];
            const unsigned sel = fq == 0 ? s0 : (fq == 1 ? s1 : (fq == 2 ? s2 : s3));
            rv[k] = unordf(sel & ~0x7Fu); rn[k] = 127 - (int)(sel & 0x7Fu);
        }
        constexpr int NSLOT = 21;
        unsigned sk[NSLOT]; int se[NSLOT];
#pragma unroll
        for (int sidx = 0; sidx < NSLOT; ++sidx) {
            const int k = sidx < 16 ? 0 : (sidx < 19 ? 1 : (sidx == 19 ? 2 : 3));
            const int j = sidx < 16 ? sidx : (sidx < 19 ? sidx - 16 : 0);
            const int i = 4 * k + fq;
            const bool valid = (i + 1) * (j + 1) <= 16;
            const float v2 = unordf(kk[1][j] & ~0x7Fu); const int n2 = 127 - (int)(kk[1][j] & 0x7Fu);
            const unsigned kx = (ordf(rv[k] + v2) & ~0x7Fu) | (unsigned)(127 - (fq * 32 + sidx));
            sk[sidx] = valid ? kx : 0u; se[sidx] = rn[k] * 128 + n2;
        }
        float top[16]; int eid[16];
#pragma unroll
        for (int rd = 0; rd < 16; ++rd) {
            unsigned m = 0u;
#pragma unroll
            for (int i = 0; i < NSLOT; ++i) m = max(m, sk[i]);
            m = xmax16(m); m = xmax32(m);
            int pay = 0;
#pragma unroll
            for (int i = 0; i < NSLOT; ++i) { const bool hit = sk[i] == m; pay |= hit ? se[i] : 0; sk[i] = hit ? 0u : sk[i]; }
            pay = (int)xor32(xor16((unsigned)pay));
            top[rd] = unordf(m & ~0x7Fu); eid[rd] = pay;
        }
        float sum = 0.f; const float mx = top[0];
#pragma unroll
        for (int rd = 0; rd < 16; ++rd) { top[rd] = __expf(top[rd] - mx); sum += top[rd]; }
        const float inv = 1.f / sum;
        if (fq == 0) {
            int* ep = EIDX + (size_t)t * 128 + hd * 16; float* gp = GW + (size_t)t * 128 + hd * 16;
#pragma unroll
            for (int q4 = 0; q4 < 4; ++q4) {
                *(int4*)(ep + 4 * q4) = make_int4(eid[4 * q4], eid[4 * q4 + 1], eid[4 * q4 + 2], eid[4 * q4 + 3]);
                *(f32x4*)(gp + 4 * q4) = (f32x4){top[4 * q4] * inv, top[4 * q4 + 1] * inv, top[4 * q4 + 2] * inv, top[4 * q4 + 3] * inv};
            }
        }
    }
}

typedef int i32x4 __attribute__((ext_vector_type(4)));
constexpr int TOK_PER_WAVE = 36;

constexpr int NPASS = 2;
__device__ __forceinline__ void pu_idx(const int* EIDX, const bf16* H, int t, int sl, int g, int c8, i32x4 (&e4)[4], v4u& hs0, v4u& hs1) {
#pragma unroll
    for (int q = 0; q < 4; ++q) e4[q] = *(const i32x4*)(EIDX + (size_t)t * 128 + g * 16 + 4 * q);
    const bf16* hp = H + (size_t)t * DM + 128 * sl + 16 * c8;
    hs0 = *(const v4u*)hp; hs1 = *(const v4u*)(hp + 8);
}
__device__ __forceinline__ void pu_rows(const char* tab, const i32x4 (&e4)[4], v4u (&r)[16]) {
#pragma unroll
    for (int i = 0; i < 16; ++i) r[i] = *(const v4u*)(tab + ((unsigned)e4[i >> 2][i & 3] << 7));
}
__device__ __forceinline__ void pu_compute(const v4u (&r)[16], const v4u hs0, const v4u hs1, LAS float* accp, bool first, int c8) {
    f32x2 h[8];
#pragma unroll
    for (int k = 0; k < 4; ++k) { h[k] = (f32x2){bflo(hs0[k]), bfhi(hs0[k])}; h[4 + k] = (f32x2){bflo(hs1[k]), bfhi(hs1[k])}; }
    float pd[16];
#pragma unroll
    for (int i = 0; i < 16; ++i) { const v4u u = r[i];
        f32x2 s2 = (f32x2){0.f, 0.f};
#pragma unroll
        for (int k = 0; k < 4; ++k) { s2 += __builtin_amdgcn_cvt_pk_f32_fp8((int)u[k], false) * h[2 * k]; s2 += __builtin_amdgcn_cvt_pk_f32_fp8((int)u[k], true) * h[2 * k + 1]; }
        pd[i] = s2[0] + s2[1]; }
    const bool b0 = c8 & 1, b1 = (c8 >> 1) & 1, b2 = (c8 >> 2) & 1;
    float r1[8], r2[4], r3[2];
#pragma unroll
    for (int q = 0; q < 8; ++q) { const float keep = b0 ? pd[q + 8] : pd[q], send = b0 ? pd[q] : pd[q + 8]; r1[q] = keep + dpp_f<0xB1>(send); }
#pragma unroll
    for (int q = 0; q < 4; ++q) { const float keep = b1 ? r1[q + 4] : r1[q], send = b1 ? r1[q] : r1[q + 4]; r2[q] = keep + dpp_f<0x4E>(send); }
#pragma unroll
    for (int q = 0; q < 2; ++q) { const float keep = b2 ? r2[q + 2] : r2[q], send = b2 ? r2[q] : r2[q + 2];
        const float up = dpp_f<0x104>(send), dn = dpp_f<0x114>(send); r3[q] = keep + (b2 ? dn : up); }
    LAS f32x2* ap = (LAS f32x2*)(accp + 8 * (c8 & 1) + 4 * ((c8 >> 1) & 1) + 2 * (c8 >> 2));
    f32x2 v = (f32x2){r3[0], r3[1]}; if (!first) v += *ap; *ap = v;
}
__device__ __forceinline__ void phase_peer_u(const Args& a, LAS unsigned char* lds, int slot, int wv, int wave, int lane) {
    const int g = lane >> 3, c8 = lane & 7;
    const bf16* H = (const bf16*)(a.ws + WS_HBUF); const int* EIDX = (const int*)(a.ws + WS_EIDX); const char* UB = (const char*)(a.ws + WS_UB);
    float* PD = (float*)(a.ws + WS_PD);
    LAS float* acc = (LAS float*)lds + wave * (TOK_PER_WAVE * 128) + g * 16;
    constexpr int NIT = NPASS * TOK_PER_WAVE;
#define PU_TAB(n) (UB + (size_t)(((n) / TOK_PER_WAVE) * 8 + slot) * ((size_t)NEXP * 128) + c8 * 16)
#define PU_SL(n) (((n) / TOK_PER_WAVE) * 8 + slot)
#define PU_T(n) (wv + 256 * ((n) % TOK_PER_WAVE))
    i32x4 eA[4], eB[4], eN[4]; v4u hA0, hA1, hB0, hB1, hN0, hN1; v4u rA[16], rB[16];
    pu_idx(EIDX, H, PU_T(0), PU_SL(0), g, c8, eA, hA0, hA1);
    pu_idx(EIDX, H, PU_T(1), PU_SL(1), g, c8, eB, hB0, hB1);
    pu_rows(PU_TAB(0), eA, rA);
#pragma unroll 1
    for (int n = 0; n < NIT; n += 2) {
        pu_rows(PU_TAB(n + 1), eB, rB);
        { const int m = n + 2 < NIT ? n + 2 : n; pu_idx(EIDX, H, PU_T(m), PU_SL(m), g, c8, eN, hN0, hN1); }
        pu_compute(rA, hA0, hA1, acc + (n % TOK_PER_WAVE) * 128, n < TOK_PER_WAVE, c8);
        { const int m = n + 2 < NIT ? n + 2 : n; pu_rows(PU_TAB(m), eN, rA); hA0 = hN0; hA1 = hN1; }
        { const int m = n + 3 < NIT ? n + 3 : n + 1; pu_idx(EIDX, H, PU_T(m), PU_SL(m), g, c8, eN, hN0, hN1); }
        pu_compute(rB, hB0, hB1, acc + ((n + 1) % TOK_PER_WAVE) * 128, n + 1 < TOK_PER_WAVE, c8);
#pragma unroll
        for (int q = 0; q < 4; ++q) eB[q] = eN[q];
        hB0 = hN0; hB1 = hN1;
    }
#undef PU_TAB
#undef PU_SL
#undef PU_T
    LDS_WAIT();
    LAS float* accw = (LAS float*)lds + wave * (TOK_PER_WAVE * 128);
    if (lane < 32) {
#pragma unroll 4
        for (int ti = 0; ti < TOK_PER_WAVE; ++ti) { const int t = wv + 256 * ti;
            *(f32x4*)(PD + ((size_t)slot * NTOK + t) * 128 + 4 * lane) = *(const LAS f32x4*)(accw + ti * 128 + 4 * lane); }
    }
}

__device__ __forceinline__ void phase_peer_act(const Args& a, int gw, int NGW, int lane) {
    const float* PD = (const float*)(a.ws + WS_PD); const float* GW = (const float*)(a.ws + WS_GW); float* ACT = (float*)(a.ws + WS_ACT);
    const int* EIDX = (const int*)(a.ws + WS_EIDX); const float* SU = (const float*)(a.ws + WS_SU); const float* SV = SU + NEXP;
    for (int t = gw; t < NTOK; t += NGW) {
        f32x2 d = (f32x2){0.f, 0.f};
#pragma unroll
        for (int x = 0; x < 8; ++x) d += *(const f32x2*)(PD + ((size_t)x * NTOK + t) * 128 + 2 * lane);
        const f32x2 gwv = *(const f32x2*)(GW + (size_t)t * 128 + 2 * lane);
        const int e0 = EIDX[(size_t)t * 128 + 2 * lane], e1 = EIDX[(size_t)t * 128 + 2 * lane + 1];
        *(unsigned*)((bf16*)ACT + (size_t)t * 128 + 2 * lane) = pk2(gelu_tanh(d[0] * SU[e0]) * gwv[0] * SV[e0], gelu_tanh(d[1] * SU[e1]) * gwv[1] * SV[e1]);
    }
}

__device__ __forceinline__ void pv_idx(const int* EIDX, const float* ACT, int t, int g, i32x4 (&e4)[4], v4u (&ac)[2]) {
#pragma unroll
    for (int q = 0; q < 4; ++q) e4[q] = *(const i32x4*)(EIDX + (size_t)t * 128 + g * 16 + 4 * q);
    const bf16* ap = (const bf16*)ACT + (size_t)t * 128 + g * 16;
    ac[0] = *(const v4u*)ap; ac[1] = *(const v4u*)(ap + 8);
}
__device__ __forceinline__ void pv_compute(const Args& a, float* xout, const v4u (&r)[16], const v4u (&ac)[2], int t, int sl, int g, int c8) {
    const float* MOD = (const float*)(a.ws + WS_MOD);
    const int mb = t < NPROMPT ? (t >> 11) : 4 + ((t - NPROMPT) >> 3);
    const int cc = 128 * sl + 16 * c8 + 8 * (g & 1) + 4 * ((g >> 1) & 1) + 2 * (g >> 2);
    f32x2 o[8];
#pragma unroll
    for (int q = 0; q < 8; ++q) o[q] = (f32x2){0.f, 0.f};
#pragma unroll
    for (int i = 0; i < 16; ++i) {
        const v4u u = r[i]; const unsigned aw = ac[i >> 3][(i >> 1) & 3]; const float w = (i & 1) ? bfhi(aw) : bflo(aw); const f32x2 w2 = (f32x2){w, w};
#pragma unroll
        for (int k = 0; k < 4; ++k) { o[2 * k] += __builtin_amdgcn_cvt_pk_f32_fp8((int)u[k], false) * w2; o[2 * k + 1] += __builtin_amdgcn_cvt_pk_f32_fp8((int)u[k], true) * w2; }
    }
    float of[16];
#pragma unroll
    for (int q = 0; q < 8; ++q) { of[2 * q] = o[q][0]; of[2 * q + 1] = o[q][1]; }
    const bool b0 = g & 1, b1 = (g >> 1) & 1, b2 = (g >> 2) & 1;
    float r1[8], r2[4], r3[2];
#pragma unroll
    for (int q = 0; q < 8; ++q) { const float keep = b0 ? of[q + 8] : of[q], send = b0 ? of[q] : of[q + 8]; r1[q] = keep + dpp_f<0x128>(send); }
#pragma unroll
    for (int q = 0; q < 4; ++q) { const float keep = b1 ? r1[q + 4] : r1[q], send = b1 ? r1[q] : r1[q + 4];
        r2[q] = keep + __builtin_bit_cast(float, __builtin_amdgcn_ds_swizzle(__builtin_bit_cast(int, send), 0x401F)); }
#pragma unroll
    for (int q = 0; q < 2; ++q) { const float keep = b2 ? r2[q + 2] : r2[q], send = b2 ? r2[q] : r2[q + 2]; r3[q] = keep + __shfl_xor(send, 32); }
    *(unsigned*)((bf16*)xout + (size_t)t * DM + cc) = pk2(r3[0], r3[1]);
}
__device__ __forceinline__ void phase_peer_v(const Args& a, float* xout, int slot, int wv, int lane) {
    const int g = lane >> 3, c8 = lane & 7;
    const int* EIDX = (const int*)(a.ws + WS_EIDX); const char* VB = (const char*)(a.ws + WS_VB); const float* ACT = (const float*)(a.ws + WS_ACT);
    constexpr int NIT = NPASS * TOK_PER_WAVE;
#define PV_TAB(n) (VB + (size_t)(((n) / TOK_PER_WAVE) * 8 + slot) * ((size_t)NEXP * 128) + c8 * 16)
#define PV_SL(n) (((n) / TOK_PER_WAVE) * 8 + slot)
#define PV_T(n) (wv + 256 * ((n) % TOK_PER_WAVE))
    i32x4 eA[4], eB[4], eN[4]; v4u aA[2], aB[2], aN[2]; v4u rA[16], rB[16];
    pv_idx(EIDX, ACT, PV_T(0), g, eA, aA);
    pv_idx(EIDX, ACT, PV_T(1), g, eB, aB);
    pu_rows(PV_TAB(0), eA, rA);
#pragma unroll 1
    for (int n = 0; n < NIT; n += 2) {
        pu_rows(PV_TAB(n + 1), eB, rB);
        { const int m = n + 2 < NIT ? n + 2 : n; pv_idx(EIDX, ACT, PV_T(m), g, eN, aN); }
        pv_compute(a, xout, rA, aA, PV_T(n), PV_SL(n), g, c8);
        { const int m = n + 2 < NIT ? n + 2 : n; pu_rows(PV_TAB(m), eN, rA);
#pragma unroll
          for (int q = 0; q < 2; ++q) aA[q] = aN[q]; }
        { const int m = n + 3 < NIT ? n + 3 : n + 1; pv_idx(EIDX, ACT, PV_T(m), g, eN, aN); }
        pv_compute(a, xout, rB, aB, PV_T(n + 1), PV_SL(n + 1), g, c8);
#pragma unroll
        for (int q = 0; q < 4; ++q) eB[q] = eN[q];
        aB[0] = aN[0]; aB[1] = aN[1];
    }
#undef PV_TAB
#undef PV_SL
#undef PV_T
}

__device__ __forceinline__ void phase_final_norm(const Args& a, int gw, int NGW, int lane) {
    const float* fg = a.in[I_FG];
    f32x4 pend[8]; int prow = -1;
    for (int row = gw; row < NTOK; row += NGW) {
        const float* xr = row < NPROMPT ? a.in[I_XP] + (size_t)row * DM : a.in[I_XS] + (size_t)(row - NPROMPT) * DM;
        const int mb = row < NPROMPT ? (row >> 11) : 4 + ((row - NPROMPT) >> 3);
        const float* g1 = (const float*)(a.ws + WS_MOD) + (size_t)mb * MODW + 2 * DM; const float* g2 = g1 + 3 * DM;
        f32x4 v[8], fv[8];
#pragma unroll
        for (int j = 0; j < 8; ++j) { const int c = 4 * lane + 256 * j;
            v[j] = *(const f32x4*)(xr + c) + *(const f32x4*)(g1 + c) * ld_bf4((const bf16*)(a.ws + WS_Q) + (size_t)row * DM + c) + *(const f32x4*)(g2 + c) * ld_bf4((const bf16*)(a.ws + WS_PCUM) + (size_t)row * DM + c); fv[j] = *(const f32x4*)(fg + c); }
        __builtin_amdgcn_sched_barrier(0);
        if (prow >= 0) {
#pragma unroll
            for (int j = 0; j < 8; ++j) __builtin_nontemporal_store(pend[j], (f32x4*)(a.out + (size_t)prow * DM + 4 * lane + 256 * j));
        }
        __builtin_amdgcn_sched_barrier(0);
        float ss = 0.f;
#pragma unroll
        for (int j = 0; j < 8; ++j) ss += (v[j][0] * v[j][0] + v[j][1] * v[j][1]) + (v[j][2] * v[j][2] + v[j][3] * v[j][3]);
        const float rstd = rsqrtf(wave_sum(ss) * (1.f / DM) + EPS);
#pragma unroll
        for (int j = 0; j < 8; ++j) pend[j] = v[j] * rstd * fv[j];
        prow = row;
    }
    if (prow >= 0) {
#pragma unroll
        for (int j = 0; j < 8; ++j) __builtin_nontemporal_store(pend[j], (f32x4*)(a.out + (size_t)prow * DM + 4 * lane + 256 * j));
    }
}

constexpr int NPH = 16;
__global__ void __launch_bounds__(NWAVES * 64, 2) fwd(Args a) {
    extern __shared__ __attribute__((aligned(16))) unsigned char lds_raw[];
    LAS unsigned char* lds = (LAS unsigned char*)lds_raw;
    volatile LAS unsigned* MISC = (volatile LAS unsigned*)(lds + MISC_OFF);
    const int tid = threadIdx.x, lane = tid & 63, wave = __builtin_amdgcn_readfirstlane(tid >> 6);
    const int G = gridDim.x; const int bx = blockIdx.x; const int vcu = (G % 8 == 0) ? (bx % 8) * (G / 8) + bx / 8 : bx;
    const int gw = vcu * NWAVES + wave, NGW = G * NWAVES;
    for (int u = tid; u < (LDS_BYTES - LDSCTL_OFF) / 4; u += NWAVES * 64) ((LAS unsigned*)(lds + LDSCTL_OFF))[u] = 0u;
    __syncthreads();
    const int lo = a.ph_lo, hi = a.ph_hi;
    unsigned* barw = (unsigned*)(a.ws + WS_CTL) + CW_BAR;
    XcdBarrier bar; bar.bar = barw; bar.x = 0; bar.st = nullptr;
    if (hi - lo > 1) bar = xcd_barrier_post(barw, MISC + 8);
    if (lo < 0) cg::this_grid().sync();
#ifndef ONLY
#define ONLY -1
#endif
#define IN(k) (lo <= (k) && (k) < hi && (ONLY < 0 || ONLY == (k)))
#define SEAM(k) do { if (IN(k) && IN((k) + 1)) xcd_barrier(bar); } while (0)

#ifndef REPMASK
#define REPMASK 0
#endif
#define PH(k, ...) do { if (IN(k)) { __VA_ARGS__ } if (IN(k) && ((REPMASK >> (k)) & 1)) { __VA_ARGS__ } } while (0)
    PH(0, phase_convert(a, lds, vcu, G, wave, lane, tid);); SEAM(0);
    PH(1, phase_adaln(a, lds, G, wave, lane, tid);); SEAM(1);
    PH(2, phase_normmod(a, 0, gw, NGW, lane, 0, NTOK);); SEAM(2);
    constexpr int U_EARLY = 6144;
    PH(3, pg8::Gemm g{(const bf16*)(a.ws + WS_HBUF), (const bf16*)(a.ws + WS_WIN), NTOK, INC, DM}; pg8::StaticOrder S; S.init(NTOK, INC, G, bx);
          pg8::EpiBf16 E{(bf16*)(a.ws + WS_PROJ), INC};
          pg8::gemm_phase<pg8::EpiBf16, pg8::StaticOrder, true>(lds, g, S, E);
          { const int ntile = (NTOK / 256) * (INC / 256); const int rounds = (ntile + G - 1) / G; const int nf = ntile - (rounds - 1) * G;
            if (nf < G) { if (bx >= nf) cvt_table_fp8(a.in[I_PU], a.ws + WS_UB, (float*)(a.ws + WS_SU), 0, U_EARLY, (bx - nf) * NWAVES + wave, (G - nf) * NWAVES, lane); }
            else cvt_table_fp8(a.in[I_PU], a.ws + WS_UB, (float*)(a.ws + WS_SU), 0, U_EARLY, bx * NWAVES + wave, G * NWAVES, lane); }); SEAM(3);
    PH(4, phase_lru(a, lds, vcu, G, wave, lane);); SEAM(4);
    PH(5, phase_mix(a, lds, G, vcu, wave, lane, tid);); SEAM(5);
    bf16* const HB = (bf16*)(a.ws + WS_HBUF); bf16* const MQ = (bf16*)(a.ws + WS_Q); bf16* const QB = (bf16*)(a.ws + WS_HLOC);
    if (IN(6)) { pg8::Gemm g{HB, (const bf16*)(a.ws + WS_WOUT), 8192, DM, DM}; pg8::StaticOrder S; S.init(8192, DM, G, bx);
                 pg8::EpiBf16 E{MQ, DM};
                 pg8::gemm_phase<pg8::EpiBf16, pg8::StaticOrder, true>(lds, g, S, E); } SEAM(6);
    if (IN(7)) { phase_normmod(a, 1, gw, NGW, lane, 0, 8192); } SEAM(7);
    if (IN(8)) { const bool left = bx < 32;
                 pg8::Gemm g{left ? HB + (size_t)8192 * DM : HB, (const bf16*)(a.ws + (left ? WS_WOUT : WS_WQ)), left ? 1024 : 7168, DM, DM};
                 pg8::StaticOrder S; S.init(g.M, DM, left ? 32 : G - 32, left ? bx : bx - 32);
                 pg8::EpiBf16 E{left ? MQ + (size_t)8192 * DM : QB, DM};
                 pg8::gemm_phase<pg8::EpiBf16, pg8::StaticOrder, true>(lds, g, S, E); } SEAM(8);
    if (IN(9)) { phase_normmod(a, 1, gw, NGW, lane, 8192, NTOK); } SEAM(9);
    if (IN(10)) { if (bx < 64) { pg8::Gemm g{HB + (size_t)7168 * DM, (const bf16*)(a.ws + WS_WQ), 2048, DM, DM}; pg8::StaticOrder S; S.init(2048, DM, 64, bx);
                                 pg8::EpiBf16 E{QB + (size_t)7168 * DM, DM};
                                 pg8::gemm_phase<pg8::EpiBf16, pg8::StaticOrder, true>(lds, g, S, E); }
                  else { const int cw = (bx - 64) * NWAVES + wave, ncw = (G - 64) * NWAVES;
                         cvt_table_fp8(a.in[I_PU], a.ws + WS_UB, (float*)(a.ws + WS_SU), U_EARLY, NEXP, cw, ncw, lane);
                         cvt_table_fp8(a.in[I_PV], a.ws + WS_VB, (float*)(a.ws + WS_SU) + NEXP, 0, NEXP, cw, ncw, lane); } } SEAM(10);
    if (IN(11)) { phase_topk(a, lds, gw, NGW, lane, tid); } SEAM(11);
    if (IN(12)) { phase_peer_u(a, lds, bx & 7, (bx >> 3) * NWAVES + wave, wave, lane); } SEAM(12);
    if (IN(13)) { phase_peer_act(a, gw, NGW, lane); } SEAM(13);
    if (IN(14)) { phase_peer_v(a, (float*)(a.ws + WS_PCUM), bx & 7, (bx >> 3) * NWAVES + wave, lane); } SEAM(14);
    if (IN(15)) { phase_final_norm(a, gw, NGW, lane); }
#undef IN
#undef SEAM
}

extern "C" void kernel_launch(void* const* d_in, const int* in_sizes, int n_in, void* d_out, int out_size, void* d_ws, size_t ws_size, hipStream_t stream) {
    static int grid = 0;
    if (grid == 0) {
        if (n_in != 28 || ws_size < WS_END) { fprintf(stderr, "kernel_launch: unexpected n_in %d / ws_size %zu\n", n_in, ws_size); grid = -1; return; }
        int dev = 0, cus = 0, per_cu = 0;
        if (hipGetDevice(&dev) != hipSuccess || hipDeviceGetAttribute(&cus, hipDeviceAttributeMultiprocessorCount, dev) != hipSuccess) { grid = -1; return; }
        if (hipFuncSetAttribute((const void*)fwd, hipFuncAttributeMaxDynamicSharedMemorySize, LDS_BYTES) != hipSuccess) { fprintf(stderr, "kernel_launch: hipFuncSetAttribute failed\n"); grid = -1; return; }
        if (hipOccupancyMaxActiveBlocksPerMultiprocessor(&per_cu, (const void*)fwd, NWAVES * 64, LDS_BYTES) != hipSuccess || per_cu < 1) { fprintf(stderr, "kernel_launch: occupancy query says %d\n", per_cu); per_cu = 1; }
        (void)hipGetLastError();
        grid = 256;
        if (cus < 256) fprintf(stderr, "kernel_launch: %d CUs < 256: the cooperative launch will be rejected\n", cus);
    }
    if (grid < 0) return;
    (void)hipMemsetAsync((char*)d_ws + WS_CTL, 0, CTL_ZERO_BYTES, stream);
    Args a{};
    for (int i = 0; i < 28; ++i) a.in[i] = (const float*)d_in[i];
    a.out = (float*)d_out; a.ws = (unsigned char*)d_ws;
#if MK_N_LAUNCHES == 1
    a.ph_lo = 0; a.ph_hi = NPH;
    void* args[] = {&a};
    hipError_t e = hipLaunchCooperativeKernel((const void*)fwd, dim3(grid), dim3(NWAVES * 64), args, LDS_BYTES, stream);
    if (e != hipSuccess) fprintf(stderr, "cooperative launch failed: %s (grid %d)\n", hipGetErrorString(e), grid);
#else
    for (int p = 0; p < NPH; ++p) { a.ph_lo = p; a.ph_hi = p + 1; hipLaunchKernelGGL(fwd, dim3(grid), dim3(NWAVES * 64), LDS_BYTES, stream, a); }
#endif
}
```

```cpp
#include <hip/hip_runtime.h>
#include <hip/hip_cooperative_groups.h>
#include <cstdio>
#include <cstdint>
namespace cg = cooperative_groups;

#ifndef MK_N_LAUNCHES
#define MK_N_LAUNCHES 1
#endif

namespace pg8 {
#define PG8_LAS __attribute__((address_space(3)))
typedef unsigned short bf16_t;
typedef short bf16x8 __attribute__((ext_vector_type(8)));
typedef float f32x4 __attribute__((ext_vector_type(4)));
typedef unsigned u32x4 __attribute__((ext_vector_type(4)));
constexpr int BM = 256, BK = 64, HALF = 128, HTB = HALF * BK * 2, STAGE_BYTES = 8 * HTB, NXCD = 8, WGM = 8;

__host__ __device__ __forceinline__ int lds_byte(int r, int c) { const int st = (r >> 4) * 2 + (c >> 5), rr = r & 15, cc = c & 31, ob = rr * 64 + cc * 2; return st * 1024 + (ob ^ (((ob >> 9) & 1) << 5)); }
__host__ __device__ __forceinline__ void stage_rc(int b, int& R, int& C) { const int st = b / 1024, sb = b % 1024, swz = sb ^ (((sb >> 9) & 1) << 5); R = (st >> 1) * 16 + swz / 64; C = (st & 1) * 32 + (swz % 64) / 2; }
__host__ __device__ __forceinline__ int perm32(int rho) { const int n = rho >> 4, i = rho & 15; return 8 * (i >> 2) + 4 * n + (i & 3); }

struct Unit { int pm, pn; };
struct Gemm { const bf16_t* A; const bf16_t* Bt; int M, N, K; };

struct StaticOrder {
    int nM, nN, nwg, G, c;
    __host__ __device__ void init(int M, int N, int G_, int c_) { nM = M / BM; nN = N / BM; nwg = nM * nN; G = G_; c = c_; }
    __host__ __device__ bool next(int i, Unit& u) const {
        const long L = (long)i * G + c; if (L >= nwg) return false;
        int wgid = (int)L; { const int q = nwg / NXCD, r = nwg % NXCD, xcd = wgid % NXCD, off = wgid / NXCD; wgid = (xcd < r ? xcd * (q + 1) : r * (q + 1) + (xcd - r) * q) + off; }
        const int nig = WGM * nN, gid = wgid / nig, fm = gid * WGM, gsz = (nM - fm) < WGM ? (nM - fm) : WGM;
        u.pm = fm + ((wgid % nig) % gsz); u.pn = (wgid % nig) / gsz; return true;
    }
    __device__ __forceinline__ void a_ready(const Unit&) const {}
    __device__ __forceinline__ void done(const Unit&) const {}
};

__device__ __forceinline__ unsigned cvt_pk_bf16(float lo, float hi) { unsigned r; asm volatile("v_cvt_pk_bf16_f32 %0, %1, %2" : "=v"(r) : "v"(lo), "v"(hi)); return r; }

struct EpiBf16 {
    static constexpr bool PERM = true, AFTER_DRAIN = false;
    bf16_t* O; int ldc;
    __device__ __forceinline__ void operator()(const f32x4 (&acc)[2][2][4][2], const Unit& u, int wr, int wc, int fr, int fq) const {
        const int row0 = u.pm * BM + wr * 64 + fr; const int col0 = u.pn * BM + wc * 32 + 8 * fq;
#pragma unroll
        for (int ai = 0; ai < 2; ++ai)
#pragma unroll
            for (int m = 0; m < 4; ++m) { bf16_t* rowp = O + (size_t)(row0 + ai * HALF + m * 16) * ldc + col0;
#pragma unroll
                for (int bj = 0; bj < 2; ++bj) { const f32x4 v0 = acc[ai][bj][m][0], v1 = acc[ai][bj][m][1];
                    u32x4 w; w.x = cvt_pk_bf16(v0[0], v0[1]); w.y = cvt_pk_bf16(v0[2], v0[3]); w.z = cvt_pk_bf16(v1[0], v1[1]); w.w = cvt_pk_bf16(v1[2], v1[3]);
                    *(u32x4*)(rowp + bj * HALF) = w; } }
    }
};

struct EpiResGate {
    static constexpr bool PERM = true, AFTER_DRAIN = false;
    const float* xp; const float* xs; const float* mod; float* O;
    __device__ __forceinline__ void operator()(const f32x4 (&acc)[2][2][4][2], const Unit& u, int wr, int wc, int fr, int fq) const {
        const int row0 = u.pm * BM + wr * 64 + fr; const int col0 = u.pn * BM + wc * 32 + 8 * fq;
#pragma unroll
        for (int ai = 0; ai < 2; ++ai)
#pragma unroll
            for (int m = 0; m < 4; ++m) {
                const int row = row0 + ai * HALF + m * 16;
                const float* xr = row < 8192 ? xp + (size_t)row * 2048 : xs + (size_t)(row - 8192) * 2048;
                const int mb = row < 8192 ? (row >> 11) : 4 + ((row - 8192) >> 3);
                const float* gr = mod + (size_t)mb * 12288 + 2 * 2048;
                float* orow = O + (size_t)row * 2048;
#pragma unroll
                for (int bj = 0; bj < 2; ++bj)
#pragma unroll
                    for (int n = 0; n < 2; ++n) { const int c = col0 + bj * HALF + 4 * n;
                        const f32x4 xv = *(const f32x4*)(xr + c), gv = *(const f32x4*)(gr + c);
                        *(f32x4*)(orow + c) = xv + gv * acc[ai][bj][m][n]; }
            }
    }
};

template <class Epi, class Sched, bool ALIGN_EPI = false>
__device__ __forceinline__ void gemm_phase(PG8_LAS unsigned char* lds, const Gemm g, const Sched& S, const Epi& E) {
    const int tid = threadIdx.x, wid = __builtin_amdgcn_readfirstlane(tid >> 6), lane = tid & 63, wr = wid >> 2, wc = wid & 3, fr = lane & 15, fq = lane >> 4;
    const int K = g.K, nt = K / BK;
    unsigned voffA[2], voffB[2];
#pragma unroll
    for (int i = 0; i < 2; ++i) { int R, C; stage_rc(tid * 16 + i * 8192, R, C); const int Rb = Epi::PERM ? ((R & ~31) + perm32(R & 31)) : R;
        voffA[i] = (unsigned)(R * K + C) * 2u; voffB[i] = (unsigned)(Rb * K + C) * 2u; }
    const size_t kstep = (size_t)(BK * 2);
    const size_t hstep = (size_t)HALF * K * 2;
    const size_t tstep = 2 * hstep;
    const unsigned ldsw = (unsigned)wid * 1024u;
    const int aoff = lds_byte(wr * 64 + fr, fq * 8), boff = lds_byte(wc * 32 + fr, fq * 8);
#define PG8_SA(b, h) (((b) * 2 + (h)) * HTB)
#define PG8_SB(b, h) ((4 + (b) * 2 + (h)) * HTB)
#define PG8_STAGE(bufoff, gbase, voff) do { _Pragma("unroll") for (int _i = 0; _i < 2; ++_i) \
        __builtin_amdgcn_global_load_lds((const unsigned*)((const char*)(gbase) + (voff)[_i]), (PG8_LAS unsigned*)(lds + (bufoff) + ldsw + _i * 8192), 16, 0, 0); } while (0)
#define PG8_LDA(dst, b, h) do { _Pragma("unroll") for (int m = 0; m < 4; ++m) _Pragma("unroll") for (int k = 0; k < 2; ++k) dst[m][k] = *(const PG8_LAS bf16x8*)(lds + PG8_SA(b, h) + aoff + m * 2048 + k * 1024); } while (0)
#define PG8_LDB(dst, b, h) do { _Pragma("unroll") for (int n = 0; n < 2; ++n) _Pragma("unroll") for (int k = 0; k < 2; ++k) dst[n][k] = *(const PG8_LAS bf16x8*)(lds + PG8_SB(b, h) + boff + n * 2048 + k * 1024); } while (0)
#define PG8_MMA(ai, bj, At, Bt) do { __builtin_amdgcn_s_setprio(1); _Pragma("unroll") for (int m = 0; m < 4; ++m) _Pragma("unroll") for (int n = 0; n < 2; ++n) _Pragma("unroll") for (int k = 0; k < 2; ++k) \
        acc[ai][bj][m][n] = __builtin_amdgcn_mfma_f32_16x16x32_bf16(Bt[n][k], At[m][k], acc[ai][bj][m][n], 0, 0, 0); __builtin_amdgcn_s_setprio(0); } while (0)
#define PG8_WAIT_V(n) asm volatile("s_waitcnt vmcnt(" #n ")" ::: "memory")
#define PG8_WAIT_L(n) asm volatile("s_waitcnt lgkmcnt(" #n ")" ::: "memory")
#define PG8_BAR __builtin_amdgcn_s_barrier()
#define PG8_SCHED __builtin_amdgcn_sched_barrier(0)
    Unit cur, nxt; int ui = 0;
    if (!S.next(0, cur)) return;
    f32x4 acc[2][2][4][2];
#pragma unroll
    for (int a = 0; a < 2; ++a)
#pragma unroll
        for (int b = 0; b < 2; ++b)
#pragma unroll
            for (int m = 0; m < 4; ++m)
#pragma unroll
                for (int n = 0; n < 2; ++n) acc[a][b][m][n] = (f32x4){0.f, 0.f, 0.f, 0.f};
    bf16x8 At[4][2], B0[2][2], B1[2][2];
    const char* cA = (const char*)g.A + (size_t)cur.pm * tstep; const char* cB = (const char*)g.Bt + (size_t)cur.pn * tstep;
    S.a_ready(cur);
    PG8_STAGE(PG8_SB(0, 0), cB, voffB); PG8_STAGE(PG8_SB(0, 1), cB + hstep, voffB); PG8_STAGE(PG8_SA(0, 0), cA, voffA); PG8_STAGE(PG8_SA(0, 1), cA + hstep, voffA);
    if (wr == 1) PG8_BAR;
    PG8_WAIT_V(2); PG8_BAR;
    PG8_STAGE(PG8_SB(1, 0), cB + kstep, voffB); PG8_STAGE(PG8_SA(1, 0), cA + kstep, voffA); PG8_STAGE(PG8_SB(1, 1), cB + hstep + kstep, voffB);
    PG8_WAIT_V(6); PG8_BAR;
    for (;;) {
        const bool has_next = S.next(ui + 1, nxt);
        const char* nA = has_next ? (const char*)g.A + (size_t)nxt.pm * tstep : cA; const char* nB = has_next ? (const char*)g.Bt + (size_t)nxt.pn * tstep : cB;
        for (int t = 0; t < nt; t += 2) {
            const bool last = (t == nt - 2);
            const char* a1 = cA + (size_t)(t + 1) * kstep;
            const char* a2 = last ? nA : cA + (size_t)(t + 2) * kstep; const char* b2 = last ? nB : cB + (size_t)(t + 2) * kstep;
            const char* a3 = a2 + kstep; const char* b3 = b2 + kstep;
            if (last && has_next) S.a_ready(nxt);
            PG8_LDB(B0, 0, 0); PG8_LDB(B1, 0, 1); PG8_SCHED; PG8_LDA(At, 0, 0); PG8_STAGE(PG8_SA(1, 1), a1 + hstep, voffA);
            PG8_WAIT_V(8); PG8_WAIT_L(0); PG8_BAR; PG8_MMA(0, 0, At, B0); PG8_MMA(0, 1, At, B1); PG8_BAR; PG8_SCHED;
            PG8_LDA(At, 0, 1); PG8_STAGE(PG8_SB(0, 0), b2, voffB); PG8_STAGE(PG8_SB(0, 1), b2 + hstep, voffB); PG8_STAGE(PG8_SA(0, 0), a2, voffA);
            PG8_WAIT_V(8); PG8_WAIT_L(0); PG8_BAR; PG8_MMA(1, 0, At, B0); PG8_MMA(1, 1, At, B1); PG8_BAR; PG8_SCHED;
            PG8_LDB(B0, 1, 0); PG8_LDB(B1, 1, 1); PG8_SCHED; PG8_LDA(At, 1, 0); PG8_STAGE(PG8_SA(0, 1), a2 + hstep, voffA);
            PG8_WAIT_V(8); PG8_WAIT_L(0); PG8_BAR; PG8_MMA(0, 0, At, B0); PG8_MMA(0, 1, At, B1); PG8_BAR; PG8_SCHED;
            PG8_LDA(At, 1, 1); PG8_STAGE(PG8_SB(1, 0), b3, voffB); PG8_STAGE(PG8_SB(1, 1), b3 + hstep, voffB); PG8_STAGE(PG8_SA(1, 0), a3, voffA);
            PG8_WAIT_V(8); PG8_WAIT_L(0); PG8_BAR; PG8_MMA(1, 0, At, B0); PG8_MMA(1, 1, At, B1); PG8_BAR; PG8_SCHED;
        }
        if constexpr (ALIGN_EPI) { if (wr == 0) PG8_BAR; }
        E(acc, cur, wr, wc, fr, fq); S.done(cur);
        if (!has_next) break;
#pragma unroll
        for (int a = 0; a < 2; ++a)
#pragma unroll
            for (int b = 0; b < 2; ++b)
#pragma unroll
                for (int m = 0; m < 4; ++m)
#pragma unroll
                    for (int n = 0; n < 2; ++n) acc[a][b][m][n] = (f32x4){0.f, 0.f, 0.f, 0.f};
        cur = nxt; cA = nA; cB = nB; ++ui;
        if constexpr (ALIGN_EPI) { if (wr == 1) PG8_BAR; }
    }
    PG8_WAIT_V(0);
    if constexpr (!ALIGN_EPI) { if (wr == 0) PG8_BAR; }
    PG8_BAR;
#undef PG8_SA
#undef PG8_SB
#undef PG8_STAGE
#undef PG8_LDA
#undef PG8_LDB
#undef PG8_MMA
#undef PG8_WAIT_V
#undef PG8_WAIT_L
#undef PG8_BAR
#undef PG8_SCHED
}
}

constexpr int NWAVES = 8;
constexpr int DM = 2048, NTOK = 9216, NPROMPT = 8192, NMOD = 132, MODW = 12288;
constexpr int LW = 1024, INC = 5120;
constexpr int NEXP = 16384;
constexpr float EPS = 1e-6f;
constexpr size_t O_Y = 0, O_HP = 18874368, O_LCP = 18878464, O_SCP = 18890752, O_HS = 18898944, O_LCS = 19030016, O_SCS = 19423232;
constexpr size_t MiB = 1u << 20;
constexpr size_t WS_CTL = 0, CTL_ZERO_BYTES = 1 * MiB;
constexpr size_t WS_S = 1 * MiB;
constexpr size_t WS_WAT = 2 * MiB;
constexpr size_t WS_MOD = 4 * MiB;
constexpr size_t WS_WIN = 12 * MiB;
constexpr size_t WS_WOUT = 32 * MiB;
constexpr size_t WS_WQ = 40 * MiB;
constexpr size_t WS_UB = 48 * MiB;
constexpr size_t WS_VB = 112 * MiB;
constexpr size_t WS_HBUF = 176 * MiB;
constexpr size_t WS_PROJ = 212 * MiB;
constexpr size_t WS_HLOC = 302 * MiB;
constexpr size_t WS_PCUM = 338 * MiB;
constexpr size_t WS_ENDS = 374 * MiB;
constexpr size_t WS_Q = 212 * MiB;
constexpr size_t WS_EIDX = 248 * MiB;
constexpr size_t WS_GW = 253 * MiB;
constexpr size_t WS_PD = 258 * MiB;
constexpr size_t WS_ACT = 294 * MiB;
constexpr size_t WS_SU = 3 * MiB;
constexpr size_t WS_END = 376 * MiB;
constexpr int CW_BAR = 4096;

constexpr int RING_BYTES = 131072, LDSCTL_OFF = 147456, MISC_OFF = LDSCTL_OFF + 320, LDS_BYTES = 148480;

#define GAS __attribute__((address_space(1)))
#define LAS __attribute__((address_space(3)))
typedef unsigned short bf16;
typedef unsigned v4u __attribute__((ext_vector_type(4)));
typedef unsigned v2u __attribute__((ext_vector_type(2)));
typedef float f32x4 __attribute__((ext_vector_type(4)));
typedef float f32x2 __attribute__((ext_vector_type(2)));
typedef short bf16x8 __attribute__((ext_vector_type(8)));
typedef __bf16 bf16x2 __attribute__((ext_vector_type(2)));
#define RLX_AGENT __ATOMIC_RELAXED, __HIP_MEMORY_SCOPE_AGENT
#define LDS_WAIT() asm volatile("s_waitcnt lgkmcnt(0)" ::: "memory")
__device__ __forceinline__ unsigned f2bf(float f) { unsigned u = __builtin_bit_cast(unsigned, f); return (u + 0x7fffu + ((u >> 16) & 1u)) >> 16; }
__device__ __forceinline__ unsigned pk2(float lo, float hi) { return pg8::cvt_pk_bf16(lo, hi); }
__device__ __forceinline__ float bflo(unsigned u) { return __builtin_bit_cast(float, u << 16); }
__device__ __forceinline__ float bfhi(unsigned u) { return __builtin_bit_cast(float, u & 0xffff0000u); }
__device__ __forceinline__ float dot2_bf16(unsigned w, unsigned x, float acc) { return __builtin_amdgcn_fdot2_f32_bf16(__builtin_bit_cast(bf16x2, w), __builtin_bit_cast(bf16x2, x), acc, false); }

#define XB_TMO      128
#define XB_XCNT(j)  (256  + 64 * (j))
#define XB_XSUB(j)  (1280 + 64 * (j))
#define XB_XGEN(j)  (2304 + 64 * (j))
#define XB_TOP      3328
#define XB_TOPGEN   3392
#define XCD_BAR_WORDS 3456
#define XB_SPIN_CAP (1u << 22)
__device__ __forceinline__ unsigned xb_ld(unsigned* p)              { return __hip_atomic_load(p, __ATOMIC_RELAXED, __HIP_MEMORY_SCOPE_AGENT); }
__device__ __forceinline__ unsigned xb_add(unsigned* p, unsigned v) { return __hip_atomic_fetch_add(p, v, __ATOMIC_RELAXED, __HIP_MEMORY_SCOPE_AGENT); }
__device__ __forceinline__ unsigned xb_xcc_id() { return (unsigned)__builtin_amdgcn_s_getreg((3 << 11) | 20) & 0xFu; }
#define XB_SPIN(cond, bar) do { unsigned _sp = 0; while (cond) { __builtin_amdgcn_s_sleep(1); \
    if ((++_sp & 255u) == 0u) { if (xb_ld(&(bar)[XB_TMO])) break; if (_sp > XB_SPIN_CAP) { atomicAdd(&(bar)[XB_TMO], 1u); break; } } } } while (0)
struct XcdBarrier { unsigned* bar; unsigned x; volatile LAS unsigned* st; };
__device__ __forceinline__ XcdBarrier xcd_barrier_post(unsigned* bar, volatile LAS unsigned* st) {
    XcdBarrier b; b.bar = bar; b.x = xb_xcc_id(); b.st = st;
    if (threadIdx.x == 0) (void)xb_add(&bar[XB_XCNT(b.x)], 1u);
    return b;
}
__device__ __forceinline__ void xcd_barrier_complete(unsigned* bar, unsigned x, unsigned& nloc, unsigned& nx) {
    const unsigned G = gridDim.x * gridDim.y * gridDim.z;
    unsigned sum, cnt, mine, sp = 0u;
    for (;;) {
        sum = 0u; cnt = 0u; mine = 0u;
#pragma unroll
        for (unsigned j = 0; j < 16; ++j) { const unsigned c = xb_ld(&bar[XB_XCNT(j)]); sum += c; cnt += (c > 0u) ? 1u : 0u; mine = (j == x) ? c : mine; }
        if (sum == G) break;
        __builtin_amdgcn_s_sleep(1);
        if ((++sp & 255u) == 0u) { if (xb_ld(&bar[XB_TMO])) break; if (sp > XB_SPIN_CAP) { atomicAdd(&bar[XB_TMO], 1u); break; } }
    }
    nloc = mine > 0u ? mine : 1u; nx = cnt > 0u ? cnt : 1u;
}
__device__ __forceinline__ void xcd_barrier(const XcdBarrier& b) {
    asm volatile("s_waitcnt vmcnt(0)" ::: "memory");
    __syncthreads();
    if (threadIdx.x == 0) {
        unsigned* bar = b.bar;
        __builtin_amdgcn_s_waitcnt(0);
        unsigned nloc = b.st[0], nx = b.st[1];
        if (nloc == 0u) { xcd_barrier_complete(bar, b.x, nloc, nx); b.st[0] = nloc; b.st[1] = nx; }
        const unsigned old = xb_add(&bar[XB_XSUB(b.x)], 1u);
        const unsigned gen = old / nloc;
        if (old + 1u == (gen + 1u) * nloc) {
            __builtin_amdgcn_fence(__ATOMIC_RELEASE, "agent");
            asm volatile("s_waitcnt vmcnt(0)" ::: "memory");
            const unsigned og = xb_add(&bar[XB_TOP], 1u);
            const unsigned tg = og / nx;
            if (og + 1u == (tg + 1u) * nx) xb_add(&bar[XB_TOPGEN], 1u);
            else XB_SPIN(xb_ld(&bar[XB_TOPGEN]) == tg, bar);
            __builtin_amdgcn_fence(__ATOMIC_ACQUIRE, "agent");
            xb_add(&bar[XB_XGEN(b.x)], 1u);
            asm volatile("s_waitcnt vmcnt(0)" ::: "memory");
        } else {
            XB_SPIN(xb_ld(&bar[XB_XGEN(b.x)]) == gen, bar);
            __builtin_amdgcn_fence(__ATOMIC_ACQUIRE, "agent");
            asm volatile("s_waitcnt vmcnt(0)" ::: "memory");
        }
    }
    __syncthreads();
}

typedef unsigned u32x2 __attribute__((ext_vector_type(2)));
template <int CTRL> __device__ __forceinline__ float dpp_f(float v) { return __builtin_bit_cast(float, __builtin_amdgcn_update_dpp(0, __builtin_bit_cast(int, v), CTRL, 0xf, 0xf, true)); }
__device__ __forceinline__ unsigned xmax16(unsigned m) { const u32x2 r = __builtin_amdgcn_permlane16_swap(m, m, false, false); return max(r[0], r[1]); }
__device__ __forceinline__ unsigned xmax32(unsigned m) { const u32x2 r = __builtin_amdgcn_permlane32_swap(m, m, false, false); return max(r[0], r[1]); }
__device__ __forceinline__ unsigned xor16(unsigned m) { const u32x2 r = __builtin_amdgcn_permlane16_swap(m, m, false, false); return r[0] | r[1]; }
__device__ __forceinline__ unsigned xor32(unsigned m) { const u32x2 r = __builtin_amdgcn_permlane32_swap(m, m, false, false); return r[0] | r[1]; }
template <int N> __device__ __forceinline__ float dpp_shr(float v) {
    return __builtin_bit_cast(float, __builtin_amdgcn_update_dpp(0, __builtin_bit_cast(int, v), 0x110 | N, 0xf, 0xf, true));
}
__device__ __forceinline__ float wave_sum(float v) {
    v += dpp_f<0xB1>(v); v += dpp_f<0x4E>(v); v += dpp_f<0x141>(v); v += dpp_f<0x140>(v);
    v += __builtin_bit_cast(float, __builtin_amdgcn_update_dpp(0, __builtin_bit_cast(int, v), 0x142, 0xa, 0xf, false));
    v += __builtin_bit_cast(float, __builtin_amdgcn_update_dpp(0, __builtin_bit_cast(int, v), 0x143, 0xc, 0xf, false));
    return __builtin_bit_cast(float, __builtin_amdgcn_readlane(__builtin_bit_cast(int, v), 63));
}
__device__ __forceinline__ float fast_rcp(float x) { return __builtin_amdgcn_rcpf(x); }
__device__ __forceinline__ float sigmoidf_(float x) { return fast_rcp(1.f + __expf(-x)); }
__device__ __forceinline__ float gelu_tanh(float x) { const float z = 1.5957691216057308f * (x + 0.044715f * x * x * x); return x * fast_rcp(1.f + __expf(-z)); }

struct Args { const float* in[28]; float* out; unsigned char* ws; int ph_lo, ph_hi; };

enum { I_XP = 0, I_XS, I_CP, I_CS, I_SLH, I_SLC, I_SSC, I_WADA, I_BADA, I_N1G, I_N2G, I_WIN, I_LCW, I_LCB, I_LWA, I_LBA, I_LWX, I_LBX, I_LAM, I_SCW, I_GLG, I_GSG, I_WOUT, I_WQ, I_KEYS, I_PU, I_PV, I_FG };

__device__ __forceinline__ void transpose_item(const float* W, int K, int N, bf16* WT, LAS float* scr, int item, int lane) {
    const int nblk = N / 32, kb = item / nblk, nb = item % nblk, k0 = 64 * kb, n0 = 32 * nb;
#pragma unroll 8
    for (int i = 0; i < 32; ++i) { const int kk = 2 * i + (lane >> 5); scr[kk * 33 + (lane & 31)] = __builtin_nontemporal_load(W + (size_t)(k0 + kk) * N + n0 + (lane & 31)); }
    LDS_WAIT(); asm volatile("" ::: "memory");
    const int c = lane & 7;
#pragma unroll
    for (int j = 0; j < 4; ++j) { const int n = (lane >> 3) + 8 * j; const LAS float* s = scr + (8 * c) * 33 + n;
        v4u o; o.x = pk2(s[0 * 33], s[1 * 33]); o.y = pk2(s[2 * 33], s[3 * 33]); o.z = pk2(s[4 * 33], s[5 * 33]); o.w = pk2(s[6 * 33], s[7 * 33]);
        *(v4u*)(WT + (size_t)(n0 + n) * K + k0 + 8 * c) = o; }
    LDS_WAIT(); asm volatile("" ::: "memory");
}

template <int CTRL> __device__ __forceinline__ unsigned dpp_u(unsigned v) { return (unsigned)__builtin_amdgcn_update_dpp(0, (int)v, CTRL, 0xf, 0xf, true); }
__device__ __forceinline__ float wave_max_pos(float v) {
    unsigned m = __builtin_bit_cast(unsigned, v);
    m = max(m, dpp_u<0xB1>(m)); m = max(m, dpp_u<0x4E>(m)); m = max(m, dpp_u<0x141>(m)); m = max(m, dpp_u<0x140>(m));
    m = xmax16(m); m = xmax32(m);
    return __builtin_bit_cast(float, m);
}
__device__ __forceinline__ void cvt_row_store(const f32x4 (&v)[8], float mx, unsigned char* dst, float* scales, int e, int lane) {
    const float q = mx > 0.f ? 224.f / mx : 1.f;
    if (lane == 0) scales[e] = mx > 0.f ? mx * (1.f / 224.f) : 1.f;
#pragma unroll
    for (int j = 0; j < 8; ++j) {
        int w = __builtin_amdgcn_cvt_pk_fp8_f32(v[j][0] * q, v[j][1] * q, 0, false);
        w = __builtin_amdgcn_cvt_pk_fp8_f32(v[j][2] * q, v[j][3] * q, w, true);
        const int sl = 2 * j + (lane >> 5);
        *(int*)(dst + ((size_t)sl * NEXP + e) * 128 + ((4 * lane) & 127)) = w;
    }
}
__device__ __forceinline__ void cvt_table_fp8(const float* src, unsigned char* dst, float* scales, int e_lo, int e_hi, int gw, int NGW, int lane) {
    for (int e = e_lo + gw; e < e_hi; e += 2 * NGW) {
        const int e2 = e + NGW < e_hi ? e + NGW : e;
        const float* r0 = src + (size_t)e * DM; const float* r1 = src + (size_t)e2 * DM;
        f32x4 v0[8], v1[8]; float m0 = 0.f, m1 = 0.f;
#pragma unroll
        for (int j = 0; j < 8; ++j) { v0[j] = __builtin_nontemporal_load((const f32x4*)(r0 + 4 * lane + 256 * j)); v1[j] = __builtin_nontemporal_load((const f32x4*)(r1 + 4 * lane + 256 * j)); }
#pragma unroll
        for (int j = 0; j < 8; ++j) { m0 = fmaxf(m0, fmaxf(fmaxf(fabsf(v0[j][0]), fabsf(v0[j][1])), fmaxf(fabsf(v0[j][2]), fabsf(v0[j][3]))));
                                      m1 = fmaxf(m1, fmaxf(fmaxf(fabsf(v1[j][0]), fabsf(v1[j][1])), fmaxf(fabsf(v1[j][2]), fabsf(v1[j][3])))); }
        m0 = wave_max_pos(m0); m1 = wave_max_pos(m1);
        cvt_row_store(v0, m0, dst, scales, e, lane);
        cvt_row_store(v1, m1, dst, scales, e2, lane);
    }
}

__device__ __forceinline__ void phase_convert(const Args& a, LAS unsigned char* lds, int vcu, int G, int wave, int lane, int tid) {
    unsigned char* ws = a.ws;
    const size_t gtid = (size_t)vcu * 512 + tid, nthr = (size_t)G * 512;
    { bf16* S = (bf16*)(ws + WS_S);
      for (size_t i = gtid; i < (size_t)144 * 2048 / 2; i += nthr) { const int row = (int)(i / 1024), col = (int)(i % 1024) * 2;
          float v0 = 0.f, v1 = 0.f;
          if (row < NMOD) { const float* c = row < 4 ? a.in[I_CP] + (size_t)row * 2048 : a.in[I_CS] + (size_t)(row - 4) * 2048; const float c0 = c[col], c1 = c[col + 1]; v0 = c0 * sigmoidf_(c0); v1 = c1 * sigmoidf_(c1); }
          *(unsigned*)(S + (size_t)row * 2048 + col) = pk2(v0, v1); } }
    { bf16* WAT = (bf16*)(ws + WS_WAT); bf16* WXT = WAT + 65536; bf16* KB = WAT + 131072;
      for (size_t i = gtid; i < 65536; i += nthr) { const int h = (int)(i >> 12), j = (int)(i >> 6) & 63, ii = (int)i & 63;
          WAT[i] = (bf16)f2bf(a.in[I_LWA][(size_t)h * 4096 + ii * 64 + j]); WXT[i] = (bf16)f2bf(a.in[I_LWX][(size_t)h * 4096 + ii * 64 + j]); }
      for (size_t i = gtid; i < 32768; i += nthr) KB[i] = (bf16)f2bf(a.in[I_KEYS][i]); }
    { LAS float* scr = (LAS float*)(lds + wave * 16384);
      const int gw = vcu * NWAVES + wave, NGW = G * NWAVES;
      constexpr int I_IN = (DM / 64) * (INC / 32), I_O = (DM / 64) * (DM / 32);
      for (int it = gw; it < I_IN + 2 * I_O; it += NGW) {
          int r = it;
          if (r < I_IN) { transpose_item(a.in[I_WIN], DM, INC, (bf16*)(ws + WS_WIN), scr, r, lane); continue; } r -= I_IN;
          if (r < I_O) { transpose_item(a.in[I_WOUT], DM, DM, (bf16*)(ws + WS_WOUT), scr, r, lane); continue; } r -= I_O;
          transpose_item(a.in[I_WQ], DM, DM, (bf16*)(ws + WS_WQ), scr, r, lane);
      } }

}

__device__ __forceinline__ void adaln_load(const float* W, int n0, int kc, int tid, f32x4 (&r)[3]) {
#pragma unroll
    for (int j = 0; j < 3; ++j) { const int i = tid + 512 * j; const int row = i / 12, c4 = i - row * 12; r[j] = __builtin_nontemporal_load((const f32x4*)(W + (size_t)(kc * 128 + row) * MODW + n0 + 4 * c4)); }
}
__device__ __forceinline__ void adaln_stage(LAS unsigned char* buf, int tid, const f32x4 (&r)[3]) {
#pragma unroll
    for (int j = 0; j < 3; ++j) { const int i = tid + 512 * j; const int row = i / 12, c4 = i - row * 12;
#pragma unroll
        for (int e = 0; e < 4; ++e) *(LAS bf16*)(buf + (4 * c4 + e) * 272 + row * 2) = (bf16)f2bf(r[j][e]); }
}
__device__ __forceinline__ void adaln_compute(const bf16* S, LAS unsigned char* buf, int kc, int wave, int fr, int fq, f32x4 (&acc)[2][3]) {
#pragma unroll
    for (int ks = 0; ks < 4; ++ks) {
        bf16x8 bfr[3];
#pragma unroll
        for (int n = 0; n < 3; ++n) bfr[n] = *(const LAS bf16x8*)(buf + (16 * n + fr) * 272 + (32 * ks + 8 * fq) * 2);
        { const bf16x8 af = *(const bf16x8*)(S + (size_t)(16 * wave + fr) * 2048 + kc * 128 + 32 * ks + 8 * fq);
#pragma unroll
          for (int n = 0; n < 3; ++n) acc[0][n] = __builtin_amdgcn_mfma_f32_16x16x32_bf16(af, bfr[n], acc[0][n], 0, 0, 0); }
        if (wave == 0) { const bf16x8 af = *(const bf16x8*)(S + (size_t)(128 + fr) * 2048 + kc * 128 + 32 * ks + 8 * fq);
#pragma unroll
          for (int n = 0; n < 3; ++n) acc[1][n] = __builtin_amdgcn_mfma_f32_16x16x32_bf16(af, bfr[n], acc[1][n], 0, 0, 0); }
    }
}
__device__ __forceinline__ void phase_adaln(const Args& a, LAS unsigned char* lds, int G, int wave, int lane, int tid) {
    const bf16* S = (const bf16*)(a.ws + WS_S); const float* W = a.in[I_WADA]; float* MOD = (float*)(a.ws + WS_MOD);
    const int fr = lane & 15, fq = lane >> 4;
    LAS unsigned char* buf0 = lds; LAS unsigned char* buf1 = lds + 16384;
    for (int item = blockIdx.x; item < MODW / 48; item += G) {
        const int n0 = item * 48;
        f32x4 acc[2][3];
#pragma unroll
        for (int m = 0; m < 2; ++m)
#pragma unroll
            for (int n = 0; n < 3; ++n) acc[m][n] = (f32x4){0.f, 0.f, 0.f, 0.f};
        f32x4 ra[3], rb[3], rc[3], rd[3];
        adaln_load(W, n0, 0, tid, ra); adaln_load(W, n0, 1, tid, rb); adaln_load(W, n0, 2, tid, rc); adaln_load(W, n0, 3, tid, rd);
#pragma unroll 1
        for (int c = 0; c < 16; c += 4) {
            adaln_stage(buf0, tid, ra); if (c + 4 < 16) adaln_load(W, n0, c + 4, tid, ra);
            __syncthreads();
            adaln_compute(S, buf0, c, wave, fr, fq, acc);
            adaln_stage(buf1, tid, rb); if (c + 5 < 16) adaln_load(W, n0, c + 5, tid, rb);
            __syncthreads();
            adaln_compute(S, buf1, c + 1, wave, fr, fq, acc);
            adaln_stage(buf0, tid, rc); if (c + 6 < 16) adaln_load(W, n0, c + 6, tid, rc);
            __syncthreads();
            adaln_compute(S, buf0, c + 2, wave, fr, fq, acc);
            adaln_stage(buf1, tid, rd); if (c + 7 < 16) adaln_load(W, n0, c + 7, tid, rd);
            __syncthreads();
            adaln_compute(S, buf1, c + 3, wave, fr, fq, acc);
        }
#pragma unroll
        for (int mi = 0; mi < 2; ++mi) { if (mi == 1 && wave != 0) break; const int m = mi == 0 ? wave : 8;
#pragma unroll
            for (int n = 0; n < 3; ++n)
#pragma unroll
                for (int r = 0; r < 4; ++r) { const int b = 16 * m + 4 * fq + r, col = n0 + 16 * n + fr; if (b < NMOD) MOD[(size_t)b * MODW + col] = acc[mi][n][r] + a.in[I_BADA][col]; } }
        __syncthreads();
    }
}

__device__ __forceinline__ f32x4 ld_bf4(const bf16* p) { const v2u u = *(const v2u*)p; return (f32x4){bflo(u.x), bfhi(u.x), bflo(u.y), bfhi(u.y)}; }
__device__ __forceinline__ void phase_normmod(const Args& a, int which, int gw, int NGW, int lane, int row_lo, int row_hi) {
    const float* MOD = (const float*)(a.ws + WS_MOD); bf16* H = (bf16*)(a.ws + WS_HBUF);
    const float* g = a.in[which ? I_N2G : I_N1G];
    v2u pend[8]; f32x4 pendx[8]; int prow = -1;
    for (int row = row_lo + gw; row < row_hi; row += NGW) {
        const float* xr = row < NPROMPT ? a.in[I_XP] + (size_t)row * DM : a.in[I_XS] + (size_t)(row - NPROMPT) * DM;
        const int mb = row < NPROMPT ? (row >> 11) : 4 + ((row - NPROMPT) >> 3);
        const float* sh = MOD + (size_t)mb * MODW + (which ? 3 : 0) * DM; const float* sc = sh + DM;
        f32x4 v[8], gv[8], sv[8], hv[8], mx[8], g1[8];
#pragma unroll
        for (int j = 0; j < 8; ++j) { const int c = 4 * lane + 256 * j; v[j] = which ? __builtin_nontemporal_load((const f32x4*)(xr + c)) : *(const f32x4*)(xr + c); gv[j] = *(const f32x4*)(g + c); sv[j] = *(const f32x4*)(sc + c); hv[j] = *(const f32x4*)(sh + c);
            if (which) { mx[j] = ld_bf4((const bf16*)(a.ws + WS_Q) + (size_t)row * DM + c); g1[j] = *(const f32x4*)(MOD + (size_t)mb * MODW + 2 * DM + c); } }
        __builtin_amdgcn_sched_barrier(0);
        if (prow >= 0) {
#pragma unroll
            for (int j = 0; j < 8; ++j) { const int c = 4 * lane + 256 * j; *(v2u*)(H + (size_t)prow * DM + c) = pend[j]; }
        }
        __builtin_amdgcn_sched_barrier(0);
        float ss = 0.f;
#pragma unroll
        for (int j = 0; j < 8; ++j) { if (which) { v[j] = v[j] + g1[j] * mx[j]; pendx[j] = v[j]; }
            ss += (v[j][0] * v[j][0] + v[j][1] * v[j][1]) + (v[j][2] * v[j][2] + v[j][3] * v[j][3]); }
        const float rstd = rsqrtf(wave_sum(ss) * (1.f / DM) + EPS);
#pragma unroll
        for (int j = 0; j < 8; ++j) { const f32x4 o = (v[j] * rstd) * gv[j] * (sv[j] + 1.f) + hv[j]; pend[j].x = pk2(o[0], o[1]); pend[j].y = pk2(o[2], o[3]); }
        prow = row;
    }
    if (prow >= 0) {
#pragma unroll
        for (int j = 0; j < 8; ++j) { const int c = 4 * lane + 256 * j; *(v2u*)(H + (size_t)prow * DM + c) = pend[j]; }
    }
}

template <bool PROMPT>
__device__ __forceinline__ f32x4 xlru4(const bf16* PROJ, const float* stc, int r, int s, int d, int ch) {
    const bool inseq = s >= d;
    const f32x4 v = ld_bf4(PROJ + (size_t)(inseq ? r - d : r) * INC + ch);
    f32x4 h = (f32x4){0.f, 0.f, 0.f, 0.f};
    if constexpr (!PROMPT) { const int bs = (r - NPROMPT) >> 3; const int hi = inseq ? 0 : (3 + s - d); h = *(const f32x4*)(stc + ((size_t)bs * 3 + hi) * LW + ch); }
    f32x4 o;
#pragma unroll
    for (int i = 0; i < 4; ++i) o[i] = inseq ? v[i] : h[i];
    return o;
}
template <bool PROMPT>
__device__ __forceinline__ f32x4 conv4(const bf16* PROJ, const float* stc, const float* cw, const float* cb, int r, int s, int ch) {
    f32x4 o = *(const f32x4*)(cb + ch);
#pragma unroll
    for (int k = 0; k < 4; ++k) o += *(const f32x4*)(cw + k * LW + ch) * xlru4<PROMPT>(PROJ, stc, r, s, 3 - k, ch);
    return o;
}

template <bool PROMPT>
__device__ __forceinline__ void lru_fill(const Args& a, LAS unsigned char* wl, int T, int hd, int lane) {
    const bf16* PROJ = (const bf16*)(a.ws + WS_PROJ); const float* stc = a.in[I_SLC];
    const int r0 = 64 * T;
    if constexpr (PROMPT) {
        const bool has_hist = (r0 & 2047) != 0;
        for (int i = lane; i < 67 * 8; i += 64) { const int lr = i >> 3, c = i & 7;
            v4u v = (v4u){0u, 0u, 0u, 0u};
            if (lr >= 3 || has_hist) v = *(const v4u*)(PROJ + (size_t)(r0 - 3 + lr) * INC + hd * 64 + c * 8);
            *(LAS v4u*)(wl + lr * 144 + c * 16) = v; }
    } else {
        for (int i = lane; i < 88 * 8; i += 64) { const int lr = i >> 3, c = i & 7; const int k = lr / 11, j = lr - 11 * k;
            const int bs = ((r0 - NPROMPT) >> 3) + k; v4u v;
            if (j < 3) { const float* sp = stc + ((size_t)bs * 3 + j) * LW + hd * 64 + c * 8; const f32x4 f0 = *(const f32x4*)sp, f1 = *(const f32x4*)(sp + 4);
                         v.x = pk2(f0[0], f0[1]); v.y = pk2(f0[2], f0[3]); v.z = pk2(f1[0], f1[1]); v.w = pk2(f1[2], f1[3]); }
            else v = *(const v4u*)(PROJ + (size_t)(r0 + 8 * k + (j - 3)) * INC + hd * 64 + c * 8);
            *(LAS v4u*)(wl + lr * 144 + c * 16) = v; }
    }
}
template <bool PROMPT> __device__ __forceinline__ int lru_lrow(int rl) { return PROMPT ? 3 + rl : (rl >> 3) * 11 + 3 + (rl & 7); }
__device__ __forceinline__ f32x4 conv4l(const LAS unsigned char* wl, const float* cw, const float* cb, int lrow, int chl, int ch) {
    f32x4 o = *(const f32x4*)(cb + ch);
#pragma unroll
    for (int k = 0; k < 4; ++k) { const v2u u = *(const LAS v2u*)(wl + (lrow - 3 + k) * 144 + chl * 2);
        o += *(const f32x4*)(cw + k * LW + ch) * (f32x4){bflo(u.x), bfhi(u.x), bflo(u.y), bfhi(u.y)}; }
    return o;
}
__device__ __forceinline__ f32x4 conv4r(const LAS unsigned char* wl, const f32x4 (&w)[4], const f32x4 b, int lrow, int chl) {
    f32x4 o = b;
#pragma unroll
    for (int k = 0; k < 4; ++k) { const v2u u = *(const LAS v2u*)(wl + (lrow - 3 + k) * 144 + chl * 2); o += w[k] * (f32x4){bflo(u.x), bfhi(u.x), bflo(u.y), bfhi(u.y)}; }
    return o;
}
template <bool PROMPT>
__device__ __forceinline__ void lru_item(const Args& a, LAS unsigned char* wl, int T, int hd, int lane, int ot0, int ot1) {
    const bf16* PROJ = (const bf16*)(a.ws + WS_PROJ); const bf16* WAT = (const bf16*)(a.ws + WS_WAT); const bf16* WXT = WAT + 65536;
    bf16* HLOC = (bf16*)(a.ws + WS_HLOC); bf16* PCUM = (bf16*)(a.ws + WS_PCUM); float* ENDS = (float*)(a.ws + WS_ENDS);
    const float* stc = a.in[I_SLC]; const float* cw = a.in[I_LCW]; const float* cb = a.in[I_LCB];
    const int fr = lane & 15, fq = lane >> 4;
    {
        constexpr bool prompt = PROMPT;
        lru_fill<PROMPT>(a, wl, T, hd, lane);
        bf16x8 bfr[4][2];
#pragma unroll
        for (int jt = 0; jt < 4; ++jt) {
            const int row = 64 * T + 16 * jt + fr; const int s = prompt ? (row & 2047) : (row & 7);
#pragma unroll
            for (int ks = 0; ks < 2; ++ks) { const int ch = hd * 64 + 32 * ks + 8 * fq;
                const int lrw = lru_lrow<PROMPT>(16 * jt + fr); const f32x4 x0 = conv4l(wl, cw, cb, lrw, 32 * ks + 8 * fq, ch), x1 = conv4l(wl, cw, cb, lrw, 32 * ks + 8 * fq + 4, ch + 4);
                v4u p; p.x = pk2(x0[0], x0[1]); p.y = pk2(x0[2], x0[3]); p.z = pk2(x1[0], x1[1]); p.w = pk2(x1[2], x1[3]); bfr[jt][ks] = __builtin_bit_cast(bf16x8, p); }
            __builtin_amdgcn_sched_barrier(0);
        }
#pragma unroll 1
        for (int ot = ot0; ot < ot1; ++ot) {
            const int ch = hd * 64 + 16 * ot + 4 * fq;
            bf16x8 wa[2], wx[2];
#pragma unroll
            for (int ks = 0; ks < 2; ++ks) { const size_t wo = ((size_t)(hd * 64 + 16 * ot + fr)) * 64 + 32 * ks + 8 * fq; wa[ks] = *(const bf16x8*)(WAT + wo); wx[ks] = *(const bf16x8*)(WXT + wo); }
            const f32x4 ba = *(const f32x4*)(a.in[I_LBA] + ch), bx = *(const f32x4*)(a.in[I_LBX] + ch), lam = *(const f32x4*)(a.in[I_LAM] + ch);
            f32x4 sp8;
#pragma unroll
            for (int r = 0; r < 4; ++r) { const float nl = -lam[r]; sp8[r] = -8.f * (fmaxf(nl, 0.f) + log1pf(__expf(-fabsf(nl)))); }
            f32x4 Pc = (f32x4){1.f, 1.f, 1.f, 1.f}, Hc = (f32x4){0.f, 0.f, 0.f, 0.f};
            f32x4 cwv[4]; const f32x4 cbv = *(const f32x4*)(cb + ch);
#pragma unroll
            for (int k = 0; k < 4; ++k) cwv[k] = *(const f32x4*)(cw + k * LW + ch);
            f32x4 h0v[4];
#pragma unroll
            for (int jt = 0; jt < 4; ++jt) { h0v[jt] = (f32x4){0.f, 0.f, 0.f, 0.f};
                if constexpr (!PROMPT) { const int bs0 = (64 * T + 16 * jt + fr - NPROMPT) >> 3; h0v[jt] = *(const f32x4*)(a.in[I_SLH] + (size_t)bs0 * LW + ch); } }
#pragma unroll
            for (int jt = 0; jt < 4; ++jt) {
                const int row = 64 * T + 16 * jt + fr; const int s = prompt ? (row & 2047) : (row & 7);
                f32x4 accA = (f32x4){0.f, 0.f, 0.f, 0.f}, accX = accA;
#pragma unroll
                for (int ks = 0; ks < 2; ++ks) {
                    accA = __builtin_amdgcn_mfma_f32_16x16x32_bf16(wa[ks], bfr[jt][ks], accA, 0, 0, 0);
                    accX = __builtin_amdgcn_mfma_f32_16x16x32_bf16(wx[ks], bfr[jt][ks], accX, 0, 0, 0); }
                const f32x4 xin = conv4r(wl, cwv, cbv, lru_lrow<PROMPT>(16 * jt + fr), 16 * ot + 4 * fq);
                f32x4 av, uv;
#pragma unroll
                for (int r = 0; r < 4; ++r) {
                    const float ra = sigmoidf_(accA[r] + ba[r]), ii = sigmoidf_(accX[r] + bx[r]);
                    const float la = sp8[r] * ra;
                    const float z = 2.f * la;
                    const float em = z > -0.1f ? -z * (1.f + z * (0.5f + z * (0.16666667f + z * 0.041666667f))) : 1.f - __expf(z);
                    av[r] = __expf(la); uv[r] = __builtin_amdgcn_sqrtf(em) * (ii * xin[r]);
                }
#pragma unroll
                for (int r = 0; r < 4; ++r) {
                    float A = av[r], U = uv[r];
                    { const float ap = dpp_shr<1>(A), up = dpp_shr<1>(U); if (prompt ? (fr >= 1) : ((fr & 7) >= 1)) { U = A * up + U; A = A * ap; } }
                    { const float ap = dpp_shr<2>(A), up = dpp_shr<2>(U); if (prompt ? (fr >= 2) : ((fr & 7) >= 2)) { U = A * up + U; A = A * ap; } }
                    { const float ap = dpp_shr<4>(A), up = dpp_shr<4>(U); if (prompt ? (fr >= 4) : ((fr & 7) >= 4)) { U = A * up + U; A = A * ap; } }
                    { const float ap = dpp_shr<8>(A), up = dpp_shr<8>(U); if (prompt && fr >= 8) { U = A * up + U; A = A * ap; } }
                    av[r] = A; uv[r] = U;
                }
                f32x4 hv, pv;
                if (prompt) {
#pragma unroll
                    for (int r = 0; r < 4; ++r) { hv[r] = uv[r] + av[r] * Hc[r]; pv[r] = av[r] * Pc[r]; }
#pragma unroll
                    for (int r = 0; r < 4; ++r) { Hc[r] = __shfl(hv[r], 15, 16); Pc[r] = __shfl(pv[r], 15, 16); }
                    if (jt == 3 && fr == 15) {
                        float* e = ENDS + ((size_t)T * LW + ch) * 2;
                        *(f32x4*)e = (f32x4){pv[0], hv[0], pv[1], hv[1]}; *(f32x4*)(e + 4) = (f32x4){pv[2], hv[2], pv[3], hv[3]};
                    }
                } else {
                    const int bs = (row - NPROMPT) >> 3;
#pragma unroll
                    for (int r = 0; r < 4; ++r) { hv[r] = uv[r] + av[r] * h0v[jt][r]; pv[r] = 0.f; }
                    if ((row & 7) == 7) *(f32x4*)(a.out + O_HS + (size_t)bs * LW + ch) = hv;
                }
                { v4u hp4; hp4.x = pk2(hv[0], hv[1]); hp4.y = pk2(hv[2], hv[3]); hp4.z = pk2(pv[0], pv[1]); hp4.w = pk2(pv[2], pv[3]);
                  *(v4u*)(HLOC + ((size_t)row * LW + ch) * 2) = hp4; }
                __builtin_amdgcn_sched_barrier(0);
            }
        }
    }
}

__device__ __forceinline__ void phase_lru(const Args& a, LAS unsigned char* lds, int vcu, int G, int wave, int lane) {
    const int gw = vcu * NWAVES + wave, NGW = G * NWAVES;
    LAS unsigned char* wl = lds + wave * 16384;
    if (G * 9 == 144 * 16) {
        { const int item = vcu * 9 + wave; const int T = item >> 4, hd = item & 15;
          if (T < 128) lru_item<true>(a, wl, T, hd, lane, 0, 4); else lru_item<false>(a, wl, T, hd, lane, 0, 4); }
        if (wave < 4) { const int item = vcu * 9 + 8; const int T = item >> 4, hd = item & 15;
          if (T < 128) lru_item<true>(a, wl, T, hd, lane, wave, wave + 1); else lru_item<false>(a, wl, T, hd, lane, wave, wave + 1); }
        return;
    }
    for (int item = gw; item < 144 * 16; item += NGW) {
        const int T = item >> 4, hd = item & 15;
        if (T < 128) lru_item<true>(a, wl, T, hd, lane, 0, 4); else lru_item<false>(a, wl, T, hd, lane, 0, 4);
    }
}

template <bool PROMPT>
__device__ __forceinline__ f32x4 cx4(const bf16* PROJ, const float* sts, int r, int s, int d, int ch) {
    const bool inseq = s >= d;
    const bf16* p = PROJ + (size_t)(inseq ? r - d : r) * INC;
    const f32x4 v = ld_bf4(p + 3072 + ch) * ld_bf4(p + 4096 + ch);
    f32x4 h = (f32x4){0.f, 0.f, 0.f, 0.f};
    if constexpr (!PROMPT) { const int bs = (r - NPROMPT) >> 3; const int hi = inseq ? 0 : (2 + s - d); h = *(const f32x4*)(sts + ((size_t)bs * 2 + hi) * LW + ch); }
    f32x4 o;
#pragma unroll
    for (int i = 0; i < 4; ++i) o[i] = inseq ? v[i] : h[i];
    return o;
}
__device__ __forceinline__ void ld_bf8(const bf16* p, f32x4& lo, f32x4& hi) { const v4u u = *(const v4u*)p; lo = (f32x4){bflo(u.x), bfhi(u.x), bflo(u.y), bfhi(u.y)}; hi = (f32x4){bflo(u.z), bfhi(u.z), bflo(u.w), bfhi(u.w)}; }
template <bool PROMPT>
__device__ __forceinline__ void cx8(const bf16* PROJ, const float* sts, int r, int s, int d, int ch, f32x4& lo, f32x4& hi) {
    const bool inseq = s >= d;
    const bf16* p = PROJ + (size_t)(inseq ? r - d : r) * INC;
    f32x4 cl, chh, xl, xh; ld_bf8(p + 3072 + ch, cl, chh); ld_bf8(p + 4096 + ch, xl, xh);
    f32x4 hl = (f32x4){0.f, 0.f, 0.f, 0.f}, hh = hl;
    if constexpr (!PROMPT) { const int bs = (r - NPROMPT) >> 3; const int hi_ = inseq ? 0 : (2 + s - d); const float* sp = sts + ((size_t)bs * 2 + hi_) * LW + ch; hl = *(const f32x4*)sp; hh = *(const f32x4*)(sp + 4); }
#pragma unroll
    for (int i = 0; i < 4; ++i) { lo[i] = inseq ? cl[i] * xl[i] : hl[i]; hi[i] = inseq ? chh[i] * xh[i] : hh[i]; }
}
template <bool PROMPT>
__device__ __forceinline__ void mix_row(const Args& a, const bf16* PROJ, bf16* H, const bf16* HLOC, const bf16* PCUM, LAS float* carry, const float* sts, const float* scw, int row, int lane) {
    constexpr bool prompt = PROMPT;
        const int s = prompt ? (row & 2047) : (row & 7); const int S = prompt ? 2048 : 8;
        const int bidx = prompt ? (row >> 11) : ((row - NPROMPT) >> 3);
        float* o_h = a.out + (prompt ? O_HP : O_HS) + (size_t)bidx * LW;
        float* o_lc = a.out + (prompt ? O_LCP : O_LCS) + ((size_t)bidx * 3 + (s - (S - 3))) * LW;
        float* o_sc = a.out + (prompt ? O_SCP : O_SCS) + ((size_t)bidx * 2 + (s - (S - 2))) * LW;
        const bf16* pr = PROJ + (size_t)row * INC;
        f32x4 ol[4], os[4]; float ssl = 0.f, sss = 0.f;
#pragma unroll
        for (int j = 0; j < 2; ++j) { const int ch8 = 8 * lane + 512 * j;
            f32x4 hl[2], pc[2], yg[2], sb[2], xl[2], c2[2], c1[2], c0[2];
            ld_bf8(HLOC + ((size_t)row * LW + ch8) * 2, hl[0], pc[0]); ld_bf8(HLOC + ((size_t)row * LW + ch8) * 2 + 8, hl[1], pc[1]);
            ld_bf8(pr + 1024 + ch8, yg[0], yg[1]); ld_bf8(pr + 2048 + ch8, sb[0], sb[1]);
            if (s >= S - 3) ld_bf8(pr + ch8, xl[0], xl[1]);
            cx8<PROMPT>(PROJ, sts, row, s, 2, ch8, c2[0], c2[1]); cx8<PROMPT>(PROJ, sts, row, s, 1, ch8, c1[0], c1[1]); cx8<PROMPT>(PROJ, sts, row, s, 0, ch8, c0[0], c0[1]);
#pragma unroll
            for (int hh = 0; hh < 2; ++hh) { const int ch = ch8 + 4 * hh;
                const f32x4 cr = *(const LAS f32x4*)(carry + ch);
                const f32x4 h = hl[hh] + pc[hh] * cr;
                f32x4 o;
#pragma unroll
                for (int r = 0; r < 4; ++r) o[r] = h[r] * gelu_tanh(yg[hh][r]);
                ol[2 * j + hh] = o; ssl += (o[0] * o[0] + o[1] * o[1]) + (o[2] * o[2] + o[3] * o[3]);
                if (prompt && s == S - 1) {
                    const float* e = (const float*)(a.ws + WS_ENDS) + ((size_t)(row >> 6) * LW + ch) * 2;
                    const f32x4 e0 = *(const f32x4*)e, e1 = *(const f32x4*)(e + 4);
                    *(f32x4*)(o_h + ch) = (f32x4){e0[1] + e0[0] * cr[0], e0[3] + e0[2] * cr[1], e1[1] + e1[0] * cr[2], e1[3] + e1[2] * cr[3]}; }
                if (s >= S - 3) *(f32x4*)(o_lc + ch) = xl[hh];
                const f32x4 cv = *(const f32x4*)(scw + ch) * c2[hh] + *(const f32x4*)(scw + LW + ch) * c1[hh] + *(const f32x4*)(scw + 2 * LW + ch) * c0[hh];
                const f32x4 q = sb[hh] * cv;
                os[2 * j + hh] = q; sss += (q[0] * q[0] + q[1] * q[1]) + (q[2] * q[2] + q[3] * q[3]);
                if (s >= S - 2) *(f32x4*)(o_sc + ch) = c0[hh];
            }
        }
        const float rl = rsqrtf(wave_sum(ssl) * (1.f / LW) + EPS), rs = rsqrtf(wave_sum(sss) * (1.f / LW) + EPS);
#pragma unroll
        for (int j = 0; j < 2; ++j) { const int ch8 = 8 * lane + 512 * j;
            v4u p, q;
#pragma unroll
            for (int hh = 0; hh < 2; ++hh) { const int ch = ch8 + 4 * hh;
                const f32x4 gl = *(const f32x4*)(a.in[I_GLG] + ch), gs = *(const f32x4*)(a.in[I_GSG] + ch);
                const f32x4 x = ol[2 * j + hh] * rl * gl, y = os[2 * j + hh] * rs * gs;
                if (hh == 0) { p.x = pk2(x[0], x[1]); p.y = pk2(x[2], x[3]); q.x = pk2(y[0], y[1]); q.y = pk2(y[2], y[3]); }
                else { p.z = pk2(x[0], x[1]); p.w = pk2(x[2], x[3]); q.z = pk2(y[0], y[1]); q.w = pk2(y[2], y[3]); } }
            *(v4u*)(H + (size_t)row * DM + ch8) = p; *(v4u*)(H + (size_t)row * DM + LW + ch8) = q; }
}
__device__ __forceinline__ void phase_mix(const Args& a, LAS unsigned char* lds, int G, int vcu, int wave, int lane, int tid) {
    const bf16* PROJ = (const bf16*)(a.ws + WS_PROJ); bf16* H = (bf16*)(a.ws + WS_HBUF);
    const bf16* HLOC = (const bf16*)(a.ws + WS_HLOC); const bf16* PCUM = (const bf16*)(a.ws + WS_PCUM); const float* ENDS = (const float*)(a.ws + WS_ENDS);
    LAS float* carry = (LAS float*)lds;
    const float* sts = a.in[I_SSC]; const float* scw = a.in[I_SCW];
    for (int item = vcu; item < NTOK / 16; item += G) {
        const int R0 = item * 16, T = R0 >> 6; const bool prompt = T < 128; const int m = prompt ? (T & 31) : 0;
        { float c0 = 0.f, c1 = 0.f;
#pragma unroll 1
          for (int jb = T - m; jb < T; jb += 8) {
              f32x4 e[8];
#pragma unroll
              for (int u = 0; u < 8; ++u) e[u] = (jb + u < T) ? *(const f32x4*)(ENDS + ((size_t)(jb + u) * LW + 2 * tid) * 2) : (f32x4){1.f, 0.f, 1.f, 0.f};
#pragma unroll
              for (int u = 0; u < 8; ++u) { c0 = e[u][1] + e[u][0] * c0; c1 = e[u][3] + e[u][2] * c1; }
          }
          carry[2 * tid] = c0; carry[2 * tid + 1] = c1; }
        __syncthreads();
#pragma unroll 1
        for (int r2 = 0; r2 < 2; ++r2) {
        if (prompt) mix_row<true>(a, PROJ, H, HLOC, PCUM, carry, sts, scw, R0 + 8 * r2 + wave, lane); else mix_row<false>(a, PROJ, H, HLOC, PCUM, carry, sts, scw, R0 + 8 * r2 + wave, lane);
        }
        __syncthreads();
    }
}

__device__ __forceinline__ unsigned ordf(float f) { const unsigned u = __builtin_bit_cast(unsigned, f); return (u & 0x80000000u) ? ~u : (u | 0x80000000u); }
__device__ __forceinline__ float unordf(unsigned k) { const unsigned u = (k & 0x80000000u) ? (k & 0x7fffffffu) : ~k; return __builtin_bit_cast(float, u); }
__device__ __forceinline__ unsigned umax3(unsigned a, unsigned b, unsigned c) { return max(max(a, b), c); }

__device__ __forceinline__ void phase_topk(const Args& a, LAS unsigned char* lds, int gw, int NGW, int lane, int tid) {
    const bf16* Q = (const bf16*)(a.ws + WS_HLOC); const bf16* KB = (const bf16*)(a.ws + WS_WAT) + 131072;
    for (int i = tid; i < 256 * 16; i += NWAVES * 64) { const int r = i >> 4, c = i & 15; *(LAS v4u*)(lds + r * 272 + c * 16) = *(const v4u*)(KB + (size_t)r * 128 + c * 8); }
    __syncthreads();
    int* EIDX = (int*)(a.ws + WS_EIDX); float* GW = (float*)(a.ws + WS_GW);
    const int fr = lane & 15, fq = lane >> 4;
    for (int item = gw; item < (NTOK / 16) * 8; item += NGW) {
        const int tt = item >> 3, hd = item & 7; const int t = 16 * tt + fr;
        unsigned kk[2][16];
#pragma unroll
        for (int p = 0; p < 2; ++p) {
            f32x4 acc[8];
#pragma unroll
            for (int n = 0; n < 8; ++n) acc[n] = (f32x4){0.f, 0.f, 0.f, 0.f};
            bf16x8 qf[4];
            const unsigned qoff = (unsigned)t * (DM * 2) + (unsigned)fq * 16u, koff = (unsigned)fr * 272u + (unsigned)fq * 16u;
#pragma unroll
            for (int ks = 0; ks < 4; ++ks) qf[ks] = *(const bf16x8*)((const char*)Q + (size_t)((hd * 256 + p * 128 + 32 * ks) * 2) + qoff);
#pragma unroll
            for (int n = 0; n < 8; ++n) {
#pragma unroll
                for (int ks = 0; ks < 4; ++ks) acc[n] = __builtin_amdgcn_mfma_f32_16x16x32_bf16(*(const LAS bf16x8*)(lds + (p * 128 + 16 * n) * 272 + ks * 64 + koff), qf[ks], acc[n], 0, 0, 0);
                if (n & 1) __builtin_amdgcn_sched_barrier(0);
            }
            unsigned key[32];
#pragma unroll
            for (int n = 0; n < 8; ++n)
#pragma unroll
                for (int r = 0; r < 4; ++r) key[n * 4 + r] = (ordf(acc[n][r]) & ~0x7Fu) | (unsigned)(127 - (16 * n + 4 * fq + r));
#pragma unroll
            for (int k = 2; k <= 32; k <<= 1)
#pragma unroll
                for (int j = k >> 1; j > 0; j >>= 1)
#pragma unroll
                    for (int i = 0; i < 32; ++i) { const int l = i ^ j;
                        if (l > i) { const unsigned hi = max(key[i], key[l]), lo = min(key[i], key[l]); const bool desc = (i & k) == 0; key[i] = desc ? hi : lo; key[l] = desc ? lo : hi; } }
            unsigned tk[16];
#pragma unroll
            for (int i = 0; i < 16; ++i) tk[i] = key[i];
#pragma unroll
            for (int st = 0; st < 2; ++st) {
                unsigned oth[16];
#pragma unroll
                for (int i = 0; i < 16; ++i) oth[i] = st == 0 ? (unsigned)__builtin_amdgcn_ds_swizzle((int)tk[i], 0x401F) : (unsigned)__shfl_xor((int)tk[i], 32);
#pragma unroll
                for (int i = 0; i < 16; ++i) tk[i] = max(tk[i], oth[15 - i]);
#pragma unroll
                for (int j = 8; j > 0; j >>= 1)
#pragma unroll
                    for (int i = 0; i < 16; ++i) { const int l = i ^ j; if (l > i) { const unsigned hi = max(tk[i], tk[l]), lo = min(tk[i], tk[l]); tk[i] = hi; tk[l] = lo; } }
            }
#pragma unroll
            for (int i = 0; i < 16; ++i) kk[p][i] = tk[i];
        }
        float rv[4]; int rn[4];
#pragma unroll
        for (int k = 0; k < 4; ++k) {
            const unsigned s0 = kk[0][4 * k], s1 = kk[0][4 * k + 1], s2 = kk[0][4 * k + 2], s3 = kk[0][4 * k + 3];
            const unsigned sel = fq == 0 ? s0 : (fq == 1 ? s1 : (fq == 2 ? s2 : s3));
            rv[k] = unordf(sel & ~0x7Fu); rn[k] = 127 - (int)(sel & 0x7Fu);
        }
        constexpr int NSLOT = 21;
        unsigned sk[NSLOT]; int se[NSLOT];
#pragma unroll
        for (int sidx = 0; sidx < NSLOT; ++sidx) {
            const int k = sidx < 16 ? 0 : (sidx < 19 ? 1 : (sidx == 19 ? 2 : 3));
            const int j = sidx < 16 ? sidx : (sidx < 19 ? sidx - 16 : 0);
            const int i = 4 * k + fq;
            const bool valid = (i + 1) * (j + 1) <= 16;
            const float v2 = unordf(kk[1][j] & ~0x7Fu); const int n2 = 127 - (int)(kk[1][j] & 0x7Fu);
            const unsigned kx = (ordf(rv[k] + v2) & ~0x7Fu) | (unsigned)(127 - (fq * 32 + sidx));
            sk[sidx] = valid ? kx : 0u; se[sidx] = rn[k] * 128 + n2;
        }
        float top[16]; int eid[16];
#pragma unroll
        for (int rd = 0; rd < 16; ++rd) {
            unsigned m = 0u;
#pragma unroll
            for (int i = 0; i < NSLOT; ++i) m = max(m, sk[i]);
            m = xmax16(m); m = xmax32(m);
            int pay = 0;
#pragma unroll
            for (int i = 0; i < NSLOT; ++i) { const bool hit = sk[i] == m; pay |= hit ? se[i] : 0; sk[i] = hit ? 0u : sk[i]; }
            pay = (int)xor32(xor16((unsigned)pay));
            top[rd] = unordf(m & ~0x7Fu); eid[rd] = pay;
        }
        float sum = 0.f; const float mx = top[0];
#pragma unroll
        for (int rd = 0; rd < 16; ++rd) { top[rd] = __expf(top[rd] - mx); sum += top[rd]; }
        const float inv = 1.f / sum;
        if (fq == 0) {
            int* ep = EIDX + (size_t)t * 128 + hd * 16; float* gp = GW + (size_t)t * 128 + hd * 16;
#pragma unroll
            for (int q4 = 0; q4 < 4; ++q4) {
                *(int4*)(ep + 4 * q4) = make_int4(eid[4 * q4], eid[4 * q4 + 1], eid[4 * q4 + 2], eid[4 * q4 + 3]);
                *(f32x4*)(gp + 4 * q4) = (f32x4){top[4 * q4] * inv, top[4 * q4 + 1] * inv, top[4 * q4 + 2] * inv, top[4 * q4 + 3] * inv};
            }
        }
    }
}

typedef int i32x4 __attribute__((ext_vector_type(4)));
constexpr int TOK_PER_WAVE = 36;

constexpr int NPASS = 2;
__device__ __forceinline__ void pu_idx(const int* EIDX, const bf16* H, int t, int sl, int g, int c8, i32x4 (&e4)[4], v4u& hs0, v4u& hs1) {
#pragma unroll
    for (int q = 0; q < 4; ++q) e4[q] = *(const i32x4*)(EIDX + (size_t)t * 128 + g * 16 + 4 * q);
    const bf16* hp = H + (size_t)t * DM + 128 * sl + 16 * c8;
    hs0 = *(const v4u*)hp; hs1 = *(const v4u*)(hp + 8);
}
__device__ __forceinline__ void pu_rows(const char* tab, const i32x4 (&e4)[4], v4u (&r)[16]) {
#pragma unroll
    for (int i = 0; i < 16; ++i) r[i] = *(const v4u*)(tab + ((unsigned)e4[i >> 2][i & 3] << 7));
}
__device__ __forceinline__ void pu_compute(const v4u (&r)[16], const v4u hs0, const v4u hs1, LAS float* accp, bool first, int c8) {
    f32x2 h[8];
#pragma unroll
    for (int k = 0; k < 4; ++k) { h[k] = (f32x2){bflo(hs0[k]), bfhi(hs0[k])}; h[4 + k] = (f32x2){bflo(hs1[k]), bfhi(hs1[k])}; }
    float pd[16];
#pragma unroll
    for (int i = 0; i < 16; ++i) { const v4u u = r[i];
        f32x2 s2 = (f32x2){0.f, 0.f};
#pragma unroll
        for (int k = 0; k < 4; ++k) { s2 += __builtin_amdgcn_cvt_pk_f32_fp8((int)u[k], false) * h[2 * k]; s2 += __builtin_amdgcn_cvt_pk_f32_fp8((int)u[k], true) * h[2 * k + 1]; }
        pd[i] = s2[0] + s2[1]; }
    const bool b0 = c8 & 1, b1 = (c8 >> 1) & 1, b2 = (c8 >> 2) & 1;
    float r1[8], r2[4], r3[2];
#pragma unroll
    for (int q = 0; q < 8; ++q) { const float keep = b0 ? pd[q + 8] : pd[q], send = b0 ? pd[q] : pd[q + 8]; r1[q] = keep + dpp_f<0xB1>(send); }
#pragma unroll
    for (int q = 0; q < 4; ++q) { const float keep = b1 ? r1[q + 4] : r1[q], send = b1 ? r1[q] : r1[q + 4]; r2[q] = keep + dpp_f<0x4E>(send); }
#pragma unroll
    for (int q = 0; q < 2; ++q) { const float keep = b2 ? r2[q + 2] : r2[q], send = b2 ? r2[q] : r2[q + 2];
        const float up = dpp_f<0x104>(send), dn = dpp_f<0x114>(send); r3[q] = keep + (b2 ? dn : up); }
    LAS f32x2* ap = (LAS f32x2*)(accp + 8 * (c8 & 1) + 4 * ((c8 >> 1) & 1) + 2 * (c8 >> 2));
    f32x2 v = (f32x2){r3[0], r3[1]}; if (!first) v += *ap; *ap = v;
}
__device__ __forceinline__ void phase_peer_u(const Args& a, LAS unsigned char* lds, int slot, int wv, int wave, int lane) {
    const int g = lane >> 3, c8 = lane & 7;
    const bf16* H = (const bf16*)(a.ws + WS_HBUF); const int* EIDX = (const int*)(a.ws + WS_EIDX); const char* UB = (const char*)(a.ws + WS_UB);
    float* PD = (float*)(a.ws + WS_PD);
    LAS float* acc = (LAS float*)lds + wave * (TOK_PER_WAVE * 128) + g * 16;
    constexpr int NIT = NPASS * TOK_PER_WAVE;
#define PU_TAB(n) (UB + (size_t)(((n) / TOK_PER_WAVE) * 8 + slot) * ((size_t)NEXP * 128) + c8 * 16)
#define PU_SL(n) (((n) / TOK_PER_WAVE) * 8 + slot)
#define PU_T(n) (wv + 256 * ((n) % TOK_PER_WAVE))
    i32x4 eA[4], eB[4], eN[4]; v4u hA0, hA1, hB0, hB1, hN0, hN1; v4u rA[16], rB[16];
    pu_idx(EIDX, H, PU_T(0), PU_SL(0), g, c8, eA, hA0, hA1);
    pu_idx(EIDX, H, PU_T(1), PU_SL(1), g, c8, eB, hB0, hB1);
    pu_rows(PU_TAB(0), eA, rA);
#pragma unroll 1
    for (int n = 0; n < NIT; n += 2) {
        pu_rows(PU_TAB(n + 1), eB, rB);
        { const int m = n + 2 < NIT ? n + 2 : n; pu_idx(EIDX, H, PU_T(m), PU_SL(m), g, c8, eN, hN0, hN1); }
        pu_compute(rA, hA0, hA1, acc + (n % TOK_PER_WAVE) * 128, n < TOK_PER_WAVE, c8);
        { const int m = n + 2 < NIT ? n + 2 : n; pu_rows(PU_TAB(m), eN, rA); hA0 = hN0; hA1 = hN1; }
        { const int m = n + 3 < NIT ? n + 3 : n + 1; pu_idx(EIDX, H, PU_T(m), PU_SL(m), g, c8, eN, hN0, hN1); }
        pu_compute(rB, hB0, hB1, acc + ((n + 1) % TOK_PER_WAVE) * 128, n + 1 < TOK_PER_WAVE, c8);
#pragma unroll
        for (int q = 0; q < 4; ++q) eB[q] = eN[q];
        hB0 = hN0; hB1 = hN1;
    }
#undef PU_TAB
#undef PU_SL
#undef PU_T
    LDS_WAIT();
    LAS float* accw = (LAS float*)lds + wave * (TOK_PER_WAVE * 128);
    if (lane < 32) {
#pragma unroll 4
        for (int ti = 0; ti < TOK_PER_WAVE; ++ti) { const int t = wv + 256 * ti;
            const f32x4 v = *(const LAS f32x4*)(accw + ti * 128 + 4 * lane); v2u pk; pk.x = pk2(v[0], v[1]); pk.y = pk2(v[2], v[3]);
            *(v2u*)((bf16*)PD + ((size_t)slot * NTOK + t) * 128 + 4 * lane) = pk; }
    }
}

__device__ __forceinline__ void phase_peer_act(const Args& a, int gw, int NGW, int lane) {
    const float* PD = (const float*)(a.ws + WS_PD); const float* GW = (const float*)(a.ws + WS_GW); float* ACT = (float*)(a.ws + WS_ACT);
    const int* EIDX = (const int*)(a.ws + WS_EIDX); const float* SU = (const float*)(a.ws + WS_SU); const float* SV = SU + NEXP;
    for (int t = gw; t < NTOK; t += NGW) {
        f32x2 d = (f32x2){0.f, 0.f};
#pragma unroll
        for (int x = 0; x < 8; ++x) { const unsigned u = *(const unsigned*)((const bf16*)PD + ((size_t)x * NTOK + t) * 128 + 2 * lane); d += (f32x2){bflo(u), bfhi(u)}; }
        const f32x2 gwv = *(const f32x2*)(GW + (size_t)t * 128 + 2 * lane);
        const int e0 = EIDX[(size_t)t * 128 + 2 * lane], e1 = EIDX[(size_t)t * 128 + 2 * lane + 1];
        *(unsigned*)((bf16*)ACT + (size_t)t * 128 + 2 * lane) = pk2(gelu_tanh(d[0] * SU[e0]) * gwv[0] * SV[e0], gelu_tanh(d[1] * SU[e1]) * gwv[1] * SV[e1]);
    }
}

__device__ __forceinline__ void pv_idx(const int* EIDX, const float* ACT, int t, int g, i32x4 (&e4)[4], v4u (&ac)[2]) {
#pragma unroll
    for (int q = 0; q < 4; ++q) e4[q] = *(const i32x4*)(EIDX + (size_t)t * 128 + g * 16 + 4 * q);
    const bf16* ap = (const bf16*)ACT + (size_t)t * 128 + g * 16;
    ac[0] = *(const v4u*)ap; ac[1] = *(const v4u*)(ap + 8);
}
__device__ __forceinline__ void pv_compute(const Args& a, float* xout, const v4u (&r)[16], const v4u (&ac)[2], int t, int sl, int g, int c8) {
    const float* MOD = (const float*)(a.ws + WS_MOD);
    const int mb = t < NPROMPT ? (t >> 11) : 4 + ((t - NPROMPT) >> 3);
    const int cc = 128 * sl + 16 * c8 + 8 * (g & 1) + 4 * ((g >> 1) & 1) + 2 * (g >> 2);
    f32x2 o[8];
#pragma unroll
    for (int q = 0; q < 8; ++q) o[q] = (f32x2){0.f, 0.f};
#pragma unroll
    for (int i = 0; i < 16; ++i) {
        const v4u u = r[i]; const unsigned aw = ac[i >> 3][(i >> 1) & 3]; const float w = (i & 1) ? bfhi(aw) : bflo(aw); const f32x2 w2 = (f32x2){w, w};
#pragma unroll
        for (int k = 0; k < 4; ++k) { o[2 * k] += __builtin_amdgcn_cvt_pk_f32_fp8((int)u[k], false) * w2; o[2 * k + 1] += __builtin_amdgcn_cvt_pk_f32_fp8((int)u[k], true) * w2; }
    }
    float of[16];
#pragma unroll
    for (int q = 0; q < 8; ++q) { of[2 * q] = o[q][0]; of[2 * q + 1] = o[q][1]; }
    const bool b0 = g & 1, b1 = (g >> 1) & 1, b2 = (g >> 2) & 1;
    float r1[8], r2[4], r3[2];
#pragma unroll
    for (int q = 0; q < 8; ++q) { const float keep = b0 ? of[q + 8] : of[q], send = b0 ? of[q] : of[q + 8]; r1[q] = keep + dpp_f<0x128>(send); }
#pragma unroll
    for (int q = 0; q < 4; ++q) { const float keep = b1 ? r1[q + 4] : r1[q], send = b1 ? r1[q] : r1[q + 4];
        r2[q] = keep + __builtin_bit_cast(float, __builtin_amdgcn_ds_swizzle(__builtin_bit_cast(int, send), 0x401F)); }
#pragma unroll
    for (int q = 0; q < 2; ++q) { const float keep = b2 ? r2[q + 2] : r2[q], send = b2 ? r2[q] : r2[q + 2]; r3[q] = keep + __shfl_xor(send, 32); }
    *(unsigned*)((bf16*)xout + (size_t)t * DM + cc) = pk2(r3[0], r3[1]);
}
__device__ __forceinline__ void phase_peer_v(const Args& a, float* xout, int slot, int wv, int lane) {
    const int g = lane >> 3, c8 = lane & 7;
    const int* EIDX = (const int*)(a.ws + WS_EIDX); const char* VB = (const char*)(a.ws + WS_VB); const float* ACT = (const float*)(a.ws + WS_ACT);
    constexpr int NIT = NPASS * TOK_PER_WAVE;
#define PV_TAB(n) (VB + (size_t)(((n) / TOK_PER_WAVE) * 8 + slot) * ((size_t)NEXP * 128) + c8 * 16)
#define PV_SL(n) (((n) / TOK_PER_WAVE) * 8 + slot)
#define PV_T(n) (wv + 256 * ((n) % TOK_PER_WAVE))
    i32x4 eA[4], eB[4], eN[4]; v4u aA[2], aB[2], aN[2]; v4u rA[16], rB[16];
    pv_idx(EIDX, ACT, PV_T(0), g, eA, aA);
    pv_idx(EIDX, ACT, PV_T(1), g, eB, aB);
    pu_rows(PV_TAB(0), eA, rA);
#pragma unroll 1
    for (int n = 0; n < NIT; n += 2) {
        pu_rows(PV_TAB(n + 1), eB, rB);
        { const int m = n + 2 < NIT ? n + 2 : n; pv_idx(EIDX, ACT, PV_T(m), g, eN, aN); }
        pv_compute(a, xout, rA, aA, PV_T(n), PV_SL(n), g, c8);
        { const int m = n + 2 < NIT ? n + 2 : n; pu_rows(PV_TAB(m), eN, rA);
#pragma unroll
          for (int q = 0; q < 2; ++q) aA[q] = aN[q]; }
        { const int m = n + 3 < NIT ? n + 3 : n + 1; pv_idx(EIDX, ACT, PV_T(m), g, eN, aN); }
        pv_compute(a, xout, rB, aB, PV_T(n + 1), PV_SL(n + 1), g, c8);
#pragma unroll
        for (int q = 0; q < 4; ++q) eB[q] = eN[q];
        aB[0] = aN[0]; aB[1] = aN[1];
    }
#undef PV_TAB
#undef PV_SL
#undef PV_T
}

__device__ __forceinline__ void phase_final_norm(const Args& a, int gw, int NGW, int lane) {
    const float* fg = a.in[I_FG];
    f32x4 pend[8]; int prow = -1;
    for (int row = gw; row < NTOK; row += NGW) {
        const float* xr = row < NPROMPT ? a.in[I_XP] + (size_t)row * DM : a.in[I_XS] + (size_t)(row - NPROMPT) * DM;
        const int mb = row < NPROMPT ? (row >> 11) : 4 + ((row - NPROMPT) >> 3);
        const float* g1 = (const float*)(a.ws + WS_MOD) + (size_t)mb * MODW + 2 * DM; const float* g2 = g1 + 3 * DM;
        f32x4 v[8], fv[8];
#pragma unroll
        for (int j = 0; j < 8; ++j) { const int c = 4 * lane + 256 * j;
            v[j] = *(const f32x4*)(xr + c) + *(const f32x4*)(g1 + c) * ld_bf4((const bf16*)(a.ws + WS_Q) + (size_t)row * DM + c) + *(const f32x4*)(g2 + c) * ld_bf4((const bf16*)(a.ws + WS_PCUM) + (size_t)row * DM + c); fv[j] = *(const f32x4*)(fg + c); }
        __builtin_amdgcn_sched_barrier(0);
        if (prow >= 0) {
#pragma unroll
            for (int j = 0; j < 8; ++j) __builtin_nontemporal_store(pend[j], (f32x4*)(a.out + (size_t)prow * DM + 4 * lane + 256 * j));
        }
        __builtin_amdgcn_sched_barrier(0);
        float ss = 0.f;
#pragma unroll
        for (int j = 0; j < 8; ++j) ss += (v[j][0] * v[j][0] + v[j][1] * v[j][1]) + (v[j][2] * v[j][2] + v[j][3] * v[j][3]);
        const float rstd = rsqrtf(wave_sum(ss) * (1.f / DM) + EPS);
#pragma unroll
        for (int j = 0; j < 8; ++j) pend[j] = v[j] * rstd * fv[j];
        prow = row;
    }
    if (prow >= 0) {
#pragma unroll
        for (int j = 0; j < 8; ++j) __builtin_nontemporal_store(pend[j], (f32x4*)(a.out + (size_t)prow * DM + 4 * lane + 256 * j));
    }
}

constexpr int NPH = 16;
__global__ void __launch_bounds__(NWAVES * 64, 2) fwd(Args a) {
    extern __shared__ __attribute__((aligned(16))) unsigned char lds_raw[];
    LAS unsigned char* lds = (LAS unsigned char*)lds_raw;
    volatile LAS unsigned* MISC = (volatile LAS unsigned*)(lds + MISC_OFF);
    const int tid = threadIdx.x, lane = tid & 63, wave = __builtin_amdgcn_readfirstlane(tid >> 6);
    const int G = gridDim.x; const int bx = blockIdx.x; const int vcu = (G % 8 == 0) ? (bx % 8) * (G / 8) + bx / 8 : bx;
    const int gw = vcu * NWAVES + wave, NGW = G * NWAVES;
    for (int u = tid; u < (LDS_BYTES - LDSCTL_OFF) / 4; u += NWAVES * 64) ((LAS unsigned*)(lds + LDSCTL_OFF))[u] = 0u;
    __syncthreads();
    const int lo = a.ph_lo, hi = a.ph_hi;
    unsigned* barw = (unsigned*)(a.ws + WS_CTL) + CW_BAR;
    XcdBarrier bar; bar.bar = barw; bar.x = 0; bar.st = nullptr;
    if (hi - lo > 1) bar = xcd_barrier_post(barw, MISC + 8);
    if (lo < 0) cg::this_grid().sync();
#ifndef ONLY
#define ONLY -1
#endif
#define IN(k) (lo <= (k) && (k) < hi && (ONLY < 0 || ONLY == (k)))
#define SEAM(k) do { if (IN(k) && IN((k) + 1)) xcd_barrier(bar); } while (0)

#ifndef REPMASK
#define REPMASK 0
#endif
#define PH(k, ...) do { if (IN(k)) { __VA_ARGS__ } if (IN(k) && ((REPMASK >> (k)) & 1)) { __VA_ARGS__ } } while (0)
    PH(0, phase_convert(a, lds, vcu, G, wave, lane, tid);); SEAM(0);
    PH(1, phase_adaln(a, lds, G, wave, lane, tid);); SEAM(1);
    PH(2, phase_normmod(a, 0, gw, NGW, lane, 0, NTOK);); SEAM(2);
    constexpr int U_EARLY = 6144;
    PH(3, pg8::Gemm g{(const bf16*)(a.ws + WS_HBUF), (const bf16*)(a.ws + WS_WIN), NTOK, INC, DM}; pg8::StaticOrder S; S.init(NTOK, INC, G, bx);
          pg8::EpiBf16 E{(bf16*)(a.ws + WS_PROJ), INC};
          pg8::gemm_phase<pg8::EpiBf16, pg8::StaticOrder, true>(lds, g, S, E);
          { const int ntile = (NTOK / 256) * (INC / 256); const int rounds = (ntile + G - 1) / G; const int nf = ntile - (rounds - 1) * G;
            if (nf < G) { if (bx >= nf) cvt_table_fp8(a.in[I_PU], a.ws + WS_UB, (float*)(a.ws + WS_SU), 0, U_EARLY, (bx - nf) * NWAVES + wave, (G - nf) * NWAVES, lane); }
            else cvt_table_fp8(a.in[I_PU], a.ws + WS_UB, (float*)(a.ws + WS_SU), 0, U_EARLY, bx * NWAVES + wave, G * NWAVES, lane); }); SEAM(3);
    PH(4, phase_lru(a, lds, vcu, G, wave, lane);); SEAM(4);
    PH(5, phase_mix(a, lds, G, vcu, wave, lane, tid);); SEAM(5);
    bf16* const HB = (bf16*)(a.ws + WS_HBUF); bf16* const MQ = (bf16*)(a.ws + WS_Q); bf16* const QB = (bf16*)(a.ws + WS_HLOC);
    if (IN(6)) { pg8::Gemm g{HB, (const bf16*)(a.ws + WS_WOUT), 8192, DM, DM}; pg8::StaticOrder S; S.init(8192, DM, G, bx);
                 pg8::EpiBf16 E{MQ, DM};
                 pg8::gemm_phase<pg8::EpiBf16, pg8::StaticOrder, true>(lds, g, S, E); } SEAM(6);
    if (IN(7)) { phase_normmod(a, 1, gw, NGW, lane, 0, 8192); } SEAM(7);
    if (IN(8)) { const bool left = bx < 32;
                 pg8::Gemm g{left ? HB + (size_t)8192 * DM : HB, (const bf16*)(a.ws + (left ? WS_WOUT : WS_WQ)), left ? 1024 : 7168, DM, DM};
                 pg8::StaticOrder S; S.init(g.M, DM, left ? 32 : G - 32, left ? bx : bx - 32);
                 pg8::EpiBf16 E{left ? MQ + (size_t)8192 * DM : QB, DM};
                 pg8::gemm_phase<pg8::EpiBf16, pg8::StaticOrder, true>(lds, g, S, E); } SEAM(8);
    if (IN(9)) { phase_normmod(a, 1, gw, NGW, lane, 8192, NTOK); } SEAM(9);
    if (IN(10)) { if (bx < 64) { pg8::Gemm g{HB + (size_t)7168 * DM, (const bf16*)(a.ws + WS_WQ), 2048, DM, DM}; pg8::StaticOrder S; S.init(2048, DM, 64, bx);
                                 pg8::EpiBf16 E{QB + (size_t)7168 * DM, DM};
                                 pg8::gemm_phase<pg8::EpiBf16, pg8::StaticOrder, true>(lds, g, S, E); }
                  else { const int cw = (bx - 64) * NWAVES + wave, ncw = (G - 64) * NWAVES;
                         cvt_table_fp8(a.in[I_PU], a.ws + WS_UB, (float*)(a.ws + WS_SU), U_EARLY, NEXP, cw, ncw, lane);
                         cvt_table_fp8(a.in[I_PV], a.ws + WS_VB, (float*)(a.ws + WS_SU) + NEXP, 0, NEXP, cw, ncw, lane); } } SEAM(10);
    if (IN(11)) { phase_topk(a, lds, gw, NGW, lane, tid); } SEAM(11);
    if (IN(12)) { phase_peer_u(a, lds, bx & 7, (bx >> 3) * NWAVES + wave, wave, lane); } SEAM(12);
    if (IN(13)) { phase_peer_act(a, gw, NGW, lane); } SEAM(13);
    if (IN(14)) { phase_peer_v(a, (float*)(a.ws + WS_PCUM), bx & 7, (bx >> 3) * NWAVES + wave, lane); } SEAM(14);
    if (IN(15)) { phase_final_norm(a, gw, NGW, lane); }
#undef IN
#undef SEAM
}

extern "C" void kernel_launch(void* const* d_in, const int* in_sizes, int n_in, void* d_out, int out_size, void* d_ws, size_t ws_size, hipStream_t stream) {
    static int grid = 0;
    if (grid == 0) {
        if (n_in != 28 || ws_size < WS_END) { fprintf(stderr, "kernel_launch: unexpected n_in %d / ws_size %zu\n", n_in, ws_size); grid = -1; return; }
        int dev = 0, cus = 0, per_cu = 0;
        if (hipGetDevice(&dev) != hipSuccess || hipDeviceGetAttribute(&cus, hipDeviceAttributeMultiprocessorCount, dev) != hipSuccess) { grid = -1; return; }
        if (hipFuncSetAttribute((const void*)fwd, hipFuncAttributeMaxDynamicSharedMemorySize, LDS_BYTES) != hipSuccess) { fprintf(stderr, "kernel_launch: hipFuncSetAttribute failed\n"); grid = -1; return; }
        if (hipOccupancyMaxActiveBlocksPerMultiprocessor(&per_cu, (const void*)fwd, NWAVES * 64, LDS_BYTES) != hipSuccess || per_cu < 1) { fprintf(stderr, "kernel_launch: occupancy query says %d\n", per_cu); per_cu = 1; }
        (void)hipGetLastError();
        grid = 256;
        if (cus < 256) fprintf(stderr, "kernel_launch: %d CUs < 256: the cooperative launch will be rejected\n", cus);
    }
    if (grid < 0) return;
    (void)hipMemsetAsync((char*)d_ws + WS_CTL, 0, CTL_ZERO_BYTES, stream);
    Args a{};
    for (int i = 0; i < 28; ++i) a.in[i] = (const float*)d_in[i];
    a.out = (float*)d_out; a.ws = (unsigned char*)d_ws;
#if MK_N_LAUNCHES == 1
    a.ph_lo = 0; a.ph_hi = NPH;
    void* args[] = {&a};
    hipError_t e = hipLaunchCooperativeKernel((const void*)fwd, dim3(grid), dim3(NWAVES * 64), args, LDS_BYTES, stream);
    if (e != hipSuccess) fprintf(stderr, "cooperative launch failed: %s (grid %d)\n", hipGetErrorString(e), grid);
#else
    for (int p = 0; p < NPH; ++p) { a.ph_lo = p; a.ph_hi = p + 1; hipLaunchKernelGGL(fwd, dim3(grid), dim3(NWAVES * 64), LDS_BYTES, stream, a); }
#endif
}
```
